# Optimizing an MI355X kernel written in HIP

```python
import math
import jax, jax.numpy as jnp
from jax import lax
import numpy as np

D_MODEL = 1024
BATCH = 8
SEQ = 4096
DEPTH = 4

CHUNK = 64
Q_BLOCK = 128
EPS = 1e-6
A_HEADS = 4
A_QK_DIM = 64
A_V_DIM = 2 * A_QK_DIM
A_WIDTH = A_HEADS * A_V_DIM
B_HEADS = 4
B_K_DIM = 64
B_V_DIM = 128
B_WIDTH = B_HEADS * B_V_DIM
B_GATE_RANK = 16
B_GATE_TAU = 16.0
BRANCH_WIDTH = A_WIDTH
N_BRANCH = 2
D_FF = 4 * D_MODEL
SPLITS = (A_HEADS * 2 * A_QK_DIM,
          A_HEADS * 2 * A_QK_DIM,
          A_WIDTH,
          B_HEADS * B_K_DIM,
          B_HEADS * B_K_DIM,
          B_WIDTH,
          B_GATE_RANK,
          B_WIDTH,
          N_BRANCH * D_MODEL)
D_IN = sum(SPLITS)

kernel_name = "hybrid_diffattn_gla_gated_merge"


def rms_norm(x, gain):
    xf = x.astype(jnp.float32)
    y = xf * lax.rsqrt(jnp.mean(xf * xf, axis=-1, keepdims=True) + EPS)
    return (y * gain.astype(jnp.float32)).astype(x.dtype)


def split_columns(proj):
    outs, start = [], 0
    for width in SPLITS:
        outs.append(proj[..., start:start + width])
        start += width
    return outs


def diff_attention(aq, ak, av, q_gain, k_gain, lq1, lk1, lq2, lk2, sub_gain, lambda_init):
    B, S = aq.shape[:2]
    q = rms_norm(aq.reshape(B, S, A_HEADS, 2, A_QK_DIM), q_gain)
    k = rms_norm(ak.reshape(B, S, A_HEADS, 2, A_QK_DIM), k_gain)
    v = av.reshape(B, S, A_HEADS, A_V_DIM)
    lam = (jnp.exp(jnp.sum(lq1.astype(jnp.float32) * lk1.astype(jnp.float32)))
           - jnp.exp(jnp.sum(lq2.astype(jnp.float32) * lk2.astype(jnp.float32)))
           + lambda_init)
    scale = A_QK_DIM ** -0.5
    n_blk = S // Q_BLOCK
    qb = q.reshape(B, n_blk, Q_BLOCK, A_HEADS, 2, A_QK_DIM).transpose(1, 0, 2, 3, 4, 5)
    key_chunk = jnp.arange(S) // CHUNK

    def block(args):
        qi, idx = args
        scores = jnp.einsum('bqhmd,bkhmd->bhmqk', qi, k).astype(jnp.float32) * scale
        q_chunk = (idx * Q_BLOCK + jnp.arange(Q_BLOCK)) // CHUNK
        mask = key_chunk[None, :] <= q_chunk[:, None]
        scores = jnp.where(mask, scores, -jnp.inf)
        p = jax.nn.softmax(scores, axis=-1)
        p = p[:, :, 0] - lam * p[:, :, 1]
        return jnp.einsum('bhqk,bkhe->bqhe', p.astype(v.dtype), v)

    out = lax.map(block, (qb, jnp.arange(n_blk)))
    out = out.transpose(1, 0, 2, 3, 4).reshape(B, S, A_HEADS, A_V_DIM)
    out = rms_norm(out, sub_gain) * (1.0 - lambda_init)
    return out.reshape(B, S, A_WIDTH)


def gla(bq, bk, bv, ba, br, w_gate_up, b_gate, out_gain):
    B, S = bq.shape[:2]
    nC = S // CHUNK
    f32 = jnp.float32
    z = (ba @ w_gate_up + b_gate).astype(f32)
    g = (jax.nn.log_sigmoid(z) / B_GATE_TAU).reshape(B, nC, CHUNK, B_HEADS, B_K_DIM)
    G = jnp.cumsum(g, axis=2)
    q = bq.reshape(B, nC, CHUNK, B_HEADS, B_K_DIM).astype(f32) * (B_K_DIM ** -0.5)
    k = bk.reshape(B, nC, CHUNK, B_HEADS, B_K_DIM).astype(f32)
    v = bv.reshape(B, nC, CHUNK, B_HEADS, B_V_DIM).astype(f32)
    q_dec = q * jnp.exp(G)
    k_dec = k * jnp.exp(-G)
    causal = jnp.tril(jnp.ones((CHUNK, CHUNK), dtype=bool))
    a = jnp.einsum('bnihd,bnjhd->bnhij', q_dec, k_dec)
    a = jnp.where(causal, a, 0.0)
    o_intra = jnp.einsum('bnhij,bnjhe->bnihe', a, v)
    G_last = G[:, :, -1]
    k_state = k * jnp.exp(G_last[:, :, None] - G)
    chunk_kv = jnp.einsum('bnjhd,bnjhe->bnhde', k_state, v)

    def step(state, inp):
        decay, kv = inp
        return decay[..., None] * state + kv, state

    init = jnp.zeros((B, B_HEADS, B_K_DIM, B_V_DIM), f32)
    _, states = lax.scan(step, init, (jnp.exp(G_last).transpose(1, 0, 2, 3),
                                      chunk_kv.transpose(1, 0, 2, 3, 4)))
    states = states.transpose(1, 0, 2, 3, 4)
    o_inter = jnp.einsum('bnihd,bnhde->bnihe', q_dec, states)
    o = (o_intra + o_inter).reshape(B, S, B_HEADS, B_V_DIM)
    r = br.reshape(B, S, B_HEADS, B_V_DIM).astype(f32)
    o = rms_norm(o, out_gain) * jax.nn.silu(r)
    return o.reshape(B, S, B_WIDTH).astype(bq.dtype)


def setup_inputs(seed: int = 0) -> dict:
    key = jax.random.key(seed)
    ks = jax.random.split(key, 18)
    L, D = DEPTH, D_MODEL

    def nrm(k, shape, scale):
        return jax.random.normal(k, shape, jnp.float32) * scale

    def gain(k, shape):
        return 1.0 + 0.02 * jax.random.normal(k, shape, jnp.float32)

    return {
        "x": nrm(ks[0], (BATCH, SEQ, D), 1.0),
        "norm_mix": gain(ks[1], (L, D)),
        "w_in": nrm(ks[2], (L, D, D_IN), D ** -0.5),
        "a_q_norm": gain(ks[3], (L, A_QK_DIM)),
        "a_k_norm": gain(ks[4], (L, A_QK_DIM)),
        "a_lambda_q1": nrm(ks[5], (L, A_QK_DIM), 0.1),
        "a_lambda_k1": nrm(ks[6], (L, A_QK_DIM), 0.1),
        "a_lambda_q2": nrm(ks[7], (L, A_QK_DIM), 0.1),
        "a_lambda_k2": nrm(ks[8], (L, A_QK_DIM), 0.1),
        "a_sub_norm": gain(ks[9], (L, A_V_DIM)),
        "b_gate_up": nrm(ks[10], (L, B_GATE_RANK, B_HEADS * B_K_DIM), B_GATE_RANK ** -0.5),
        "b_gate_bias": nrm(ks[11], (L, B_HEADS * B_K_DIM), 0.1),
        "b_out_norm": gain(ks[12], (L, B_V_DIM)),
        "w_branch": nrm(ks[13], (L, N_BRANCH, BRANCH_WIDTH, D), BRANCH_WIDTH ** -0.5),
        "w_out": nrm(ks[14], (L, D, D), D ** -0.5),
        "norm_ffn": gain(ks[15], (L, D)),
        "w_up": nrm(ks[16], (L, D, D_FF), D ** -0.5),
        "w_down": nrm(ks[17], (L, D_FF, D), 0.5 * D_FF ** -0.5),
    }


def reference(x, norm_mix, w_in, a_q_norm, a_k_norm, a_lambda_q1, a_lambda_k1,
              a_lambda_q2, a_lambda_k2, a_sub_norm, b_gate_up, b_gate_bias, b_out_norm,
              w_branch, w_out, norm_ffn, w_up, w_down):
    B, S, D = x.shape
    for l in range(DEPTH):
        lambda_init = 0.8 - 0.6 * math.exp(-0.3 * l)
        u = rms_norm(x, norm_mix[l])
        proj = u @ w_in[l]
        aq, ak, av, bq, bk, bv, ba, br, gates = split_columns(proj)
        ya = diff_attention(aq, ak, av, a_q_norm[l], a_k_norm[l], a_lambda_q1[l],
                            a_lambda_k1[l], a_lambda_q2[l], a_lambda_k2[l],
                            a_sub_norm[l], lambda_init)
        yb = gla(bq, bk, bv, ba, br, b_gate_up[l], b_gate_bias[l], b_out_norm[l])
        branches = jnp.stack([ya, yb], axis=2)
        branch_proj = jnp.einsum('bsnw,nwd->bsnd', branches, w_branch[l])
        gate = jax.nn.sigmoid(gates.reshape(B, S, N_BRANCH, D))
        mixed = jnp.sum(gate * branch_proj, axis=2) @ w_out[l]
        x = x + mixed
        h = rms_norm(x, norm_ffn[l])
        x = x + jnp.square(jax.nn.relu(h @ w_up[l])) @ w_down[l]
    return x
```

```cpp
#include <hip/hip_runtime.h>
#include <cstdio>
#include <cstdint>
#include <cmath>
constexpr int NWAVES = 8;
constexpr int DM = 1024, SEQ = 4096, NB = 8, MT = NB * SEQ  , DEPTH = 4, DFF = 4096, DIN = 5136;
constexpr int NCH = 64;
constexpr int NIN_N = 4352, NIN_T = 1024;
constexpr int C_AQ = 0, C_AK = 512, C_AV = 1024, C_BQ = 1536, C_BK = 1792, C_BV = 2048, C_BA = 2560, C_BR = 2576, C_GT = 3088;
constexpr size_t MiB = 1u << 20;
constexpr size_t WS_CTL = 0, CTL_ZERO_BYTES = 512 * 1024;
constexpr size_t WS_PAR = 512 * 1024, PAR_LAYER_BYTES = 4096;
constexpr int PAR_QG = 0, PAR_KG = 64, PAR_ZB = 128, PAR_SUB = 384, PAR_OUTG = 512, PAR_LAM = 640, PAR_NEGB = 641, PAR_ONEM = 642;
constexpr int CW_BAR = 4096, CW_RANK = 8192, CW_GRP = 16384;
constexpr size_t WS_W0 = 2 * MiB, W_LAYER = (size_t)63 * MiB / 2;
constexpr size_t WO_IN_G8 = (size_t)9 * 256 * DM * 2;
constexpr size_t WO_IN_N = 0, WO_IN_T = WO_IN_N + (size_t)NIN_N * DM * 2, WO_BR = WO_IN_T + (size_t)NIN_T * DM * 2, WO_OUT = WO_BR + 2 * MiB, WO_UP = WO_OUT + 2 * MiB, WO_DN = WO_UP + 8 * MiB;
static_assert(WO_DN + 8 * MiB <= W_LAYER && WS_W0 + 4 * W_LAYER <= 128 * MiB, "weights");
constexpr size_t WS_ARENA0 = 128 * MiB, ARENA = 47 * MiB;
constexpr size_t WS_XB = 0;
constexpr size_t WS_QA = 8 * MiB, WS_KA = 12 * MiB, WS_VTA = 16 * MiB, WS_BQ = 20 * MiB, WS_BK = 22 * MiB, WS_GG = 24 * MiB  , WS_BR = 26 * MiB, WS_GT = 30 * MiB  ,
                 WS_VTB = 38 * MiB, WS_KTB = 42 * MiB, WS_GTT = 44 * MiB  ;
constexpr size_t WS_PARTF = 46 * MiB, WS_PARTA = 46 * MiB + 256 * 1024, WS_DEC = 46 * MiB + 512 * 1024;
constexpr size_t WS_END = WS_ARENA0 + 8 * ARENA;
constexpr size_t WS_MIX = WS_QA;
constexpr size_t WS_KV = WS_QA;
constexpr size_t WS_ST = WS_VTA;
constexpr size_t WS_HID = WS_QA;
static_assert(WS_HID + (size_t)SEQ * DFF * 2 <= WS_PARTF && WS_DEC + 65536 <= ARENA && WS_END <= 504 * MiB, "arena");
namespace pg8 {
#define PG8_LAS __attribute__((address_space(3)))
typedef unsigned short bf16_t;
typedef short bf16x8 __attribute__((ext_vector_type(8)));
typedef float f32x4 __attribute__((ext_vector_type(4)));
typedef unsigned u32x4 __attribute__((ext_vector_type(4)));
constexpr int BM = 256, BK = 64, HALF = 128, HTB = HALF * BK * 2  , STAGE_BYTES = 8 * HTB, NXCD = 8, WGM = 8;

__host__ __device__ __forceinline__ int lds_byte(int r, int c) { const int st = (r >> 4) * 2 + (c >> 5), rr = r & 15, cc = c & 31, ob = rr * 64 + cc * 2; return st * 1024 + (ob ^ (((ob >> 9) & 1) << 5)); }
__host__ __device__ __forceinline__ void stage_rc(int b, int& R, int& C) { const int st = b / 1024, sb = b % 1024, swz = sb ^ (((sb >> 9) & 1) << 5); R = (st >> 1) * 16 + swz / 64; C = (st & 1) * 32 + (swz % 64) / 2; }
__host__ __device__ __forceinline__ int perm32(int rho) { const int n = rho >> 4, i = rho & 15; return 8 * (i >> 2) + 4 * n + (i & 3); }

struct Unit { int pm, pn; };
struct Gemm { const bf16_t* A; const bf16_t* Bt; int M, N, K; };

struct StaticOrder {
    int nM, nN, nwg, G, c;
    __host__ __device__ void init(int M, int N, int G_, int c_) { nM = M / BM; nN = N / BM; nwg = nM * nN; G = G_; c = c_; }
    __host__ __device__ bool next(int i, Unit& u) const {
        const long L = (long)i * G + c; if (L >= nwg) return false;
        int wgid = (int)L; { const int q = nwg / NXCD, r = nwg % NXCD, xcd = wgid % NXCD, off = wgid / NXCD; wgid = (xcd < r ? xcd * (q + 1) : r * (q + 1) + (xcd - r) * q) + off; }
        const int nig = WGM * nN, gid = wgid / nig, fm = gid * WGM, gsz = (nM - fm) < WGM ? (nM - fm) : WGM;
        u.pm = fm + ((wgid % nig) % gsz); u.pn = (wgid % nig) / gsz; return true;
    }
    __device__ __forceinline__ void a_ready(const Unit&) const {}
    __device__ __forceinline__ void done(const Unit&) const {}
};

__device__ __forceinline__ unsigned cvt_pk_bf16(float lo, float hi) { unsigned r; asm volatile("v_cvt_pk_bf16_f32 %0, %1, %2" : "=v"(r) : "v"(lo), "v"(hi)); return r; }
typedef unsigned u32x2 __attribute__((ext_vector_type(2)));
typedef int i32x4 __attribute__((ext_vector_type(4))); typedef int i32x8 __attribute__((ext_vector_type(8)));
__device__ __forceinline__ i32x8 cat8(bf16x8 a, bf16x8 b) { return __builtin_shufflevector(__builtin_bit_cast(i32x4, a), __builtin_bit_cast(i32x4, b), 0, 1, 2, 3, 4, 5, 6, 7); }
__device__ __forceinline__ unsigned pk4_fp8(f32x4 v) { unsigned w = 0u; w = (unsigned)__builtin_amdgcn_cvt_pk_fp8_f32(v[0], v[1], (int)w, false); w = (unsigned)__builtin_amdgcn_cvt_pk_fp8_f32(v[2], v[3], (int)w, true); return w; }
constexpr float RMS_EPS = 1e-6f;
constexpr int MTOK = 32768;
__device__ __forceinline__ int opaque_i(int v) { asm volatile("" : "+v"(v)); return v; }
__device__ __forceinline__ float sum16(const float* p) { const f32x4 a = *(const f32x4*)p, b = *(const f32x4*)(p + 4), c = *(const f32x4*)(p + 8), d = *(const f32x4*)(p + 12);
    return (((a[0] + a[1]) + (a[2] + a[3])) + ((b[0] + b[1]) + (b[2] + b[3]))) + (((c[0] + c[1]) + (c[2] + c[3])) + ((d[0] + d[1]) + (d[2] + d[3]))); }
__device__ __forceinline__ float sigmoidf_(float v) { return __builtin_amdgcn_rcpf(1.f + __expf(-v)); }
__device__ __forceinline__ float bflo(unsigned w) { return __uint_as_float(w << 16); }
__device__ __forceinline__ float bfhi(unsigned w) { return __uint_as_float(w & 0xffff0000u); }
__device__ __forceinline__ u32x4 pack8(const f32x4 a, const f32x4 b) { u32x4 w; w.x = cvt_pk_bf16(a[0], a[1]); w.y = cvt_pk_bf16(a[2], a[3]); w.z = cvt_pk_bf16(b[0], b[1]); w.w = cvt_pk_bf16(b[2], b[3]); return w; }

struct EpiInN {
    static constexpr bool PERM = true, HAS_MID = false;
    const PG8_LAS float* ssq; unsigned char* ws; const float* par; int pn0;
    __device__ __forceinline__ void mid(f32x4 (&)[2][2][4][2], const Unit&, int, int, int, int) const {}
    __device__ __forceinline__ void operator()(const f32x4 (&acc)[2][2][4][2], const Unit& u, int wr, int wc, int fr, int fq) const {
        const int pn = u.pn + pn0, row0 = u.pm * BM + wr * 64 + fr, cw = 64 * wc + 8 * fq;
        const float qscale = 0.125f * 1.4426950408889634f;
        float rs[2][4];
#pragma unroll
        for (int ai = 0; ai < 2; ++ai)
#pragma unroll
            for (int m = 0; m < 4; ++m) rs[ai][m] = ssq[(row0 + ai * HALF + m * 16) & 4095];
        if (pn < 4) {
            const float* gn = par + (pn < 2 ? PAR_QG : PAR_KG); const float sc = pn < 2 ? qscale : 1.f;
            bf16_t* O = (bf16_t*)(ws + (pn < 2 ? WS_QA : WS_KA)); const int colb = (pn & 1) * 256 + cw;
            f32x4 gv[2][2];
#pragma unroll
            for (int bj = 0; bj < 2; ++bj)
#pragma unroll
                for (int n = 0; n < 2; ++n) gv[bj][n] = *(const f32x4*)(gn + 32 * bj + 8 * fq + 4 * n) * sc;
#pragma unroll
            for (int ai = 0; ai < 2; ++ai)
#pragma unroll
                for (int m = 0; m < 4; ++m) {
                    const float r = rs[ai][m]; f32x4 v[2][2]; float ss = 0.f;
#pragma unroll
                    for (int bj = 0; bj < 2; ++bj)
#pragma unroll
                        for (int n = 0; n < 2; ++n) { v[bj][n] = acc[ai][bj][m][n] * r; const f32x4 x = v[bj][n]; ss += (x[0] * x[0] + x[1] * x[1]) + (x[2] * x[2] + x[3] * x[3]); }
                    ss += __shfl_xor(ss, 16); ss += __shfl_xor(ss, 32);
                    const float qr = rsqrtf(ss * (1.0f / 64.0f) + RMS_EPS);
                    bf16_t* rowp = O + (size_t)(row0 + ai * HALF + m * 16) * 512 + colb;
#pragma unroll
                    for (int bj = 0; bj < 2; ++bj) *(u32x4*)(rowp + 32 * bj) = pack8(v[bj][0] * qr * gv[bj][0], v[bj][1] * qr * gv[bj][1]);
                }
        } else if (pn == 6) {
            f32x4 bz[2][2];
#pragma unroll
            for (int bj = 0; bj < 2; ++bj)
#pragma unroll
                for (int n = 0; n < 2; ++n) bz[bj][n] = *(const f32x4*)(par + PAR_ZB + cw + 32 * bj + 4 * n);
#pragma unroll
            for (int ai = 0; ai < 2; ++ai)
#pragma unroll
                for (int m = 0; m < 4; ++m) {
                    const float r = rs[ai][m]; bf16_t* rowp = (bf16_t*)(ws + WS_GG) + (size_t)(row0 + ai * HALF + m * 16) * 256 + cw;
#pragma unroll
                    for (int bj = 0; bj < 2; ++bj) { f32x4 g[2];
#pragma unroll
                        for (int n = 0; n < 2; ++n) { const f32x4 z = acc[ai][bj][m][n] * r + bz[bj][n];
#pragma unroll
                            for (int e = 0; e < 4; ++e) g[n][e] = (fminf(z[e], 0.f) - __logf(1.f + __expf(-fabsf(z[e])))) * (1.0f / 16.0f); }
                        const u32x4 gw = pack8(g[0], g[1]); *(u32x4*)(rowp + 32 * bj) = gw;
                        const int t = row0 + ai * HALF + m * 16; bf16_t* tp = (bf16_t*)(ws + WS_GTT) + ((((size_t)((t >> 12) * 4 + wc) * 64 + ((t >> 6) & 63)) * 64 + 32 * bj + 8 * fq) << 6) + (t & 63);
#pragma unroll
                        for (int i = 0; i < 4; ++i) { tp[(2 * i) * 64] = (bf16_t)(gw[i] & 0xffffu); tp[(2 * i + 1) * 64] = (bf16_t)(gw[i] >> 16); } }
                }
        } else if (pn >= 9) {
            const int colb = (pn - 9) * 256 + cw; const float k255 = 1.0f / 255.0f;
#pragma unroll
            for (int ai = 0; ai < 2; ++ai)
#pragma unroll
                for (int m = 0; m < 4; ++m) {
                    const float c = rs[ai][m] * (-1.4426950408889634f / 32.0f);     unsigned char* rowp = ws + WS_GT + (size_t)(row0 + ai * HALF + m * 16) * 2048 + colb;
#pragma unroll
                    for (int bj = 0; bj < 2; ++bj) { const f32x4 t0 = acc[ai][bj][m][0] * c, t1 = acc[ai][bj][m][1] * c; u32x2 q; q.x = 0u; q.y = 0u;
#pragma unroll
                        for (int e = 0; e < 4; ++e) {
                            q.x = __builtin_amdgcn_cvt_pk_u8_f32(__builtin_amdgcn_rcpf(__builtin_fmaf(__builtin_amdgcn_exp2f(t0[e]), k255, k255)), e, q.x);
                            q.y = __builtin_amdgcn_cvt_pk_u8_f32(__builtin_amdgcn_rcpf(__builtin_fmaf(__builtin_amdgcn_exp2f(t1[e]), k255, k255)), e, q.y); }
                        *(u32x2*)(rowp + 32 * bj) = q; }
                }
        } else {
            bf16_t* O; int ld, colb; int mode;
            float sc = 1.f;
            if (pn == 4) { O = (bf16_t*)(ws + WS_BQ); ld = 256; colb = cw; mode = 0; sc = 0.125f; }
            else if (pn == 5) { O = (bf16_t*)(ws + WS_BK); ld = 256; colb = cw; mode = 0; }
            else { O = (bf16_t*)(ws + WS_BR); ld = 512; colb = (pn - 7) * 256 + cw; mode = 1; }
#pragma unroll
            for (int ai = 0; ai < 2; ++ai)
#pragma unroll
                for (int m = 0; m < 4; ++m) {
                    const float r = rs[ai][m] * sc; bf16_t* rowp = O + (size_t)(row0 + ai * HALF + m * 16) * ld + colb;
#pragma unroll
                    for (int bj = 0; bj < 2; ++bj) { f32x4 v0 = acc[ai][bj][m][0] * r, v1 = acc[ai][bj][m][1] * r;
                        if (mode != 0) {
#pragma unroll
                            for (int e = 0; e < 4; ++e) { v0[e] *= sigmoidf_(v0[e]); v1[e] *= sigmoidf_(v1[e]); } }
                        const u32x4 gw = pack8(v0, v1); *(u32x4*)(rowp + 32 * bj) = gw;
                        if (pn == 5) {
                            const int t = opaque_i(row0) + ai * HALF + m * 16, dq = opaque_i(8 * fq); bf16_t* tp = (bf16_t*)(ws + WS_KTB) + ((((size_t)((t >> 12) * 4 + wc) * 64 + ((t >> 6) & 63)) * 64 + 32 * bj + dq) << 6) + (t & 63);
#pragma unroll
                            for (int i = 0; i < 4; ++i) { tp[(2 * i) * 64] = (bf16_t)(gw[i] & 0xffffu); tp[(2 * i + 1) * 64] = (bf16_t)(gw[i] >> 16); } } }
                }
        }
    }
};
struct EpiGate {
    static constexpr bool PERM = true, HAS_MID = false;
    const PG8_LAS float* ssq; unsigned char* ws; const float* par;
    __device__ __forceinline__ void mid(f32x4 (&)[2][2][4][2], const Unit&, int, int, int, int) const {}
    __device__ __forceinline__ void operator()(const f32x4 (&acc)[2][2][4][2], const Unit& u, int wr, int wc, int fr, int fq) const {
        const int tid_ = opaque_i(threadIdx.x), wid_ = tid_ >> 6, ln_ = tid_ & 63;
        if (u.pn == 8) {
            const int wc_ = wid_ & 3, fq_ = ln_ >> 4, row0 = u.pm * BM + (wid_ >> 2) * 64 + (ln_ & 15), cw = 64 * wc_ + 8 * fq_;
#pragma unroll
            for (int ai = 0; ai < 2; ++ai)
#pragma unroll
                for (int m = 0; m < 4; ++m) {
                    const int t = row0 + ai * HALF + m * 16; const float r = ssq[t & 4095] * (1.0f / 32.0f); bf16_t* rowp = (bf16_t*)(ws + WS_GG) + (size_t)t * 256 + cw;
#pragma unroll
                    for (int bj = 0; bj < 2; ++bj) { f32x4 g[2];
#pragma unroll
                        for (int n = 0; n < 2; ++n) { const f32x4 z = acc[ai][bj][m][n] * r + *(const f32x4*)(par + PAR_ZB + cw + 32 * bj + 4 * n);
#pragma unroll
                            for (int e = 0; e < 4; ++e) g[n][e] = (fminf(z[e], 0.f) - __logf(1.f + __expf(-fabsf(z[e])))) * (1.0f / 16.0f); }
                        const u32x4 gw = pack8(g[0], g[1]); *(u32x4*)(rowp + 32 * bj) = gw;
                        bf16_t* tp = (bf16_t*)(ws + WS_GTT) + ((((size_t)((t >> 12) * 4 + wc_) * 64 + ((t >> 6) & 63)) * 64 + 32 * bj + 8 * fq_) << 6) + (t & 63);
#pragma unroll
                        for (int i = 0; i < 4; ++i) { tp[(2 * i) * 64] = (bf16_t)(gw[i] & 0xffffu); tp[(2 * i + 1) * 64] = (bf16_t)(gw[i] >> 16); } }
                }
            return;
        }
        const int row0 = u.pm * BM + (wid_ >> 2) * 64 + (ln_ & 15), colb = u.pn * 256 + 64 * (wid_ & 3) + 8 * (ln_ >> 4); const float k255 = 1.0f / 255.0f; (void)wr; (void)wc; (void)fr; (void)fq;
#pragma unroll
        for (int ai = 0; ai < 2; ++ai)
#pragma unroll
            for (int m = 0; m < 4; ++m) {
                const float c = ssq[(row0 + ai * HALF + m * 16) & 4095] * (-1.4426950408889634f / 32.0f); unsigned char* rowp = ws + WS_GT + (size_t)(row0 + ai * HALF + m * 16) * 2048 + colb;
#pragma unroll
                for (int bj = 0; bj < 2; ++bj) { const f32x4 t0 = acc[ai][bj][m][0] * c, t1 = acc[ai][bj][m][1] * c; u32x2 q; q.x = 0u; q.y = 0u;
#pragma unroll
                    for (int e = 0; e < 4; ++e) {
                        q.x = __builtin_amdgcn_cvt_pk_u8_f32(__builtin_amdgcn_rcpf(__builtin_fmaf(__builtin_amdgcn_exp2f(t0[e]), k255, k255)), e, q.x);
                        q.y = __builtin_amdgcn_cvt_pk_u8_f32(__builtin_amdgcn_rcpf(__builtin_fmaf(__builtin_amdgcn_exp2f(t1[e]), k255, k255)), e, q.y); }
                    *(u32x2*)(rowp + 32 * bj) = q; }
            }
    }
};
struct EpiInT {
    static constexpr bool PERM = true, HAS_MID = false;
    const PG8_LAS float* ssq; unsigned char* ws; const float* par;
    __device__ __forceinline__ void mid(f32x4 (&)[2][2][4][2], const Unit&, int, int, int, int) const {}
    __device__ __forceinline__ void operator()(const f32x4 (&acc)[2][2][4][2], const Unit& u, int wr, int wc, int fr, int fq) const {
        const int pm = u.pm, tok0 = u.pn * BM + wc * 32 + 8 * fq, frow0 = (pm < 4 ? (pm & 1) * 256 : 0) + wr * 64 + fr;
        f32x4 rt[2][2];
#pragma unroll
        for (int bj = 0; bj < 2; ++bj)
#pragma unroll
            for (int n = 0; n < 2; ++n) rt[bj][n] = *(const PG8_LAS f32x4*)(ssq + ((tok0 + bj * HALF + 4 * n) & 4095));
        size_t tb_[2];
#pragma unroll
        for (int bj = 0; bj < 2; ++bj) { const int t = tok0 + bj * HALF; tb_[bj] = (size_t)((t >> 12) * 4) * 64 + ((t >> 6) & 63); }
        if (pm < 5) {
            bf16_t* O = (bf16_t*)(ws + (pm < 2 ? WS_VTA : pm < 4 ? WS_VTB : WS_KTB)); const int fl2 = pm < 4 ? 7 : 6;
#pragma unroll
            for (int ai = 0; ai < 2; ++ai)
#pragma unroll
                for (int m = 0; m < 4; ++m) { const int fr_ = frow0 + ai * HALF + m * 16, hd = fr_ >> fl2, fe = fr_ & ((1 << fl2) - 1);
#pragma unroll
                    for (int bj = 0; bj < 2; ++bj) *(u32x4*)(O + ((((tb_[bj] + (size_t)hd * 64) << fl2) + fe) << 6) + ((tok0 + bj * HALF) & 63)) = pack8(acc[ai][bj][m][0] * rt[bj][0], acc[ai][bj][m][1] * rt[bj][1]); }
        } else {
#pragma unroll
            for (int ai = 0; ai < 2; ++ai)
#pragma unroll
                for (int m = 0; m < 4; ++m) { const int fr_ = frow0 + ai * HALF + m * 16, hd = fr_ >> 6, fe = fr_ & 63; const float bz = par[PAR_ZB + fr_];
#pragma unroll
                    for (int bj = 0; bj < 2; ++bj) { bf16_t* rowp = (bf16_t*)(ws + WS_GTT) + ((((tb_[bj] + (size_t)hd * 64) << 6) + fe) << 6) + ((tok0 + bj * HALF) & 63); f32x4 g[2];
#pragma unroll
                        for (int n = 0; n < 2; ++n) { const f32x4 z = acc[ai][bj][m][n] * rt[bj][n] + bz;
#pragma unroll
                            for (int e = 0; e < 4; ++e) g[n][e] = (fminf(z[e], 0.f) - __logf(1.f + __expf(-fabsf(z[e])))) * (1.0f / 16.0f); }
                        *(u32x4*)rowp = pack8(g[0], g[1]); } }
        }
    }
};
struct EpiUp {
    static constexpr bool PERM = true, HAS_MID = false;
    const PG8_LAS float* ssq; unsigned char* ws;
    __device__ __forceinline__ void mid(f32x4 (&)[2][2][4][2], const Unit&, int, int, int, int) const {}
    __device__ __forceinline__ void operator()(const f32x4 (&acc)[2][2][4][2], const Unit& u, int wr, int wc, int fr, int fq) const {
        const int row0 = u.pm * BM + wr * 64 + fr, col0 = u.pn * BM + wc * 32 + 8 * fq;
        float rr[2][4];
#pragma unroll
        for (int ai = 0; ai < 2; ++ai)
#pragma unroll
            for (int m = 0; m < 4; ++m) rr[ai][m] = ssq[(row0 + ai * HALF + m * 16) & 4095];
#pragma unroll
        for (int ai = 0; ai < 2; ++ai)
#pragma unroll
            for (int m = 0; m < 4; ++m) { const int row = row0 + ai * HALF + m * 16; const float r = rr[ai][m];
                bf16_t* rowp = (bf16_t*)(ws + WS_HID) + (((size_t)(row >> 8) * 64 + (col0 >> 6)) * 256 + (row & 255)) * 64 + (col0 & 63);
#pragma unroll
                for (int bj = 0; bj < 2; ++bj) { f32x4 v0 = acc[ai][bj][m][0] * r, v1 = acc[ai][bj][m][1] * r;
#pragma unroll
                    for (int e = 0; e < 4; ++e) { const float a = fmaxf(v0[e], 0.f), b = fmaxf(v1[e], 0.f); v0[e] = a * a; v1[e] = b * b; }
                    *(u32x4*)(rowp + bj * (2 * 256 * 64)) = pack8(v0, v1); } }
    }
};
struct EpiRes {
    static constexpr bool PERM = true, HAS_MID = false;
    bf16_t* xb; float* ssq; float* fout; unsigned char* x8;
    __device__ __forceinline__ void mid(f32x4 (&)[2][2][4][2], const Unit&, int, int, int, int) const {}
    __device__ __forceinline__ void operator()(const f32x4 (&acc)[2][2][4][2], const Unit& u, int wr, int wc, int fr, int fq) const {
        const int row0 = u.pm * BM + wr * 64 + fr, col0 = u.pn * BM + wc * 32 + 8 * fq;
        u32x4 pre[2][4][2];
#pragma unroll
        for (int ai = 0; ai < 2; ++ai)
#pragma unroll
            for (int m = 0; m < 4; ++m)
#pragma unroll
                for (int bj = 0; bj < 2; ++bj) pre[ai][m][bj] = *(const u32x4*)(xb + (size_t)(row0 + ai * HALF + m * 16) * 1024 + col0 + bj * HALF);
#pragma unroll
        for (int ai = 0; ai < 2; ++ai)
#pragma unroll
            for (int m = 0; m < 4; ++m) { const int row = row0 + ai * HALF + m * 16; const size_t off = (size_t)row * 1024 + col0; float ss = 0.f;
#pragma unroll
                for (int bj = 0; bj < 2; ++bj) { const u32x4 w = pre[ai][m][bj];
                    const f32x4 o0 = (f32x4){bflo(w[0]), bfhi(w[0]), bflo(w[1]), bfhi(w[1])} + acc[ai][bj][m][0], o1 = (f32x4){bflo(w[2]), bfhi(w[2]), bflo(w[3]), bfhi(w[3])} + acc[ai][bj][m][1];
                    *(u32x4*)(xb + off + bj * HALF) = pack8(o0, o1);
                    if (fout) { *(f32x4*)(fout + off + bj * HALF) = o0; *(f32x4*)(fout + off + bj * HALF + 4) = o1; }
                    if (x8) { u32x2 q8; q8.x = pk4_fp8(o0); q8.y = pk4_fp8(o1); *(u32x2*)(x8 + off + bj * HALF) = q8; }
                    ss += ((o0[0] * o0[0] + o0[1] * o0[1]) + (o0[2] * o0[2] + o0[3] * o0[3])) + ((o1[0] * o1[0] + o1[1] * o1[1]) + (o1[2] * o1[2] + o1[3] * o1[3])); }
                ss += __shfl_xor(ss, 16); ss += __shfl_xor(ss, 32);
                if (fq == 0) ssq[(size_t)row * 16 + u.pn * 4 + wc] = ss; }
    }
};
struct EpiBranch {
    static constexpr bool PERM = true, HAS_MID = true;
    unsigned char* ws;
    static __device__ __forceinline__ float gq(unsigned w, int e) { return (float)((w >> (8 * e)) & 0xffu); }
    static __device__ __forceinline__ float gbc(unsigned w, int e) { return fmaxf(gq(w, e), 0.5f); }
    __device__ __forceinline__ void mid(f32x4 (&acc)[2][2][4][2], const Unit& u, int wr, int wc, int fr, int fq) const {
        const int row0 = opaque_i(u.pm * BM + wr * 64 + fr), col0 = opaque_i(u.pn * BM + wc * 32 + 8 * fq);
        u32x2 a[2][4][2], b[2][4][2];
#pragma unroll
        for (int ai = 0; ai < 2; ++ai)
#pragma unroll
            for (int m = 0; m < 4; ++m) { const unsigned char* gp = ws + WS_GT + (size_t)(row0 + ai * HALF + m * 16) * 2048 + col0;
#pragma unroll
                for (int bj = 0; bj < 2; ++bj) { a[ai][m][bj] = *(const u32x2*)(gp + bj * HALF); b[ai][m][bj] = *(const u32x2*)(gp + 1024 + bj * HALF); } }
#pragma unroll
        for (int ai = 0; ai < 2; ++ai)
#pragma unroll
            for (int m = 0; m < 4; ++m)
#pragma unroll
                for (int bj = 0; bj < 2; ++bj)
#pragma unroll
                    for (int n = 0; n < 2; ++n)
#pragma unroll
                        for (int e = 0; e < 4; ++e) acc[ai][bj][m][n][e] *= gq(a[ai][m][bj][n], e) * __builtin_amdgcn_rcpf(gbc(b[ai][m][bj][n], e));
    }
    __device__ __forceinline__ void operator()(const f32x4 (&acc)[2][2][4][2], const Unit& u, int wr, int wc, int fr, int fq) const {
        const int row0 = u.pm * BM + wr * 64 + fr, col0 = u.pn * BM + wc * 32 + 8 * fq;
        u32x2 b[2][4][2];
#pragma unroll
        for (int ai = 0; ai < 2; ++ai)
#pragma unroll
            for (int m = 0; m < 4; ++m) { const unsigned char* gp = ws + WS_GT + (size_t)(row0 + ai * HALF + m * 16) * 2048 + 1024 + col0;
#pragma unroll
                for (int bj = 0; bj < 2; ++bj) b[ai][m][bj] = *(const u32x2*)(gp + bj * HALF); }
#pragma unroll
        for (int ai = 0; ai < 2; ++ai)
#pragma unroll
            for (int m = 0; m < 4; ++m) { bf16_t* rowp = (bf16_t*)(ws + WS_MIX) + (size_t)(row0 + ai * HALF + m * 16) * 1024 + col0;
#pragma unroll
                for (int bj = 0; bj < 2; ++bj) { f32x4 v0 = acc[ai][bj][m][0], v1 = acc[ai][bj][m][1];
#pragma unroll
                    for (int e = 0; e < 4; ++e) { v0[e] *= gbc(b[ai][m][bj][0], e) * (1.0f / 255.0f); v1[e] *= gbc(b[ai][m][bj][1], e) * (1.0f / 255.0f); }
                    *(u32x4*)(rowp + bj * HALF) = pack8(v0, v1); } }
    }
};

template <class Epi, class Sched, bool ALIGN_EPI = false, bool SP2 = false, bool ATILED = false, bool F8 = false>
__device__ __forceinline__ void gemm_phase(PG8_LAS unsigned char* lds, const Gemm g, const Sched& S, const Epi& E) {
    const int tid = opaque_i(threadIdx.x), wid = __builtin_amdgcn_readfirstlane(tid >> 6), lane = tid & 63, wr = wid >> 2, wc = wid & 3, fr = lane & 15, fq = lane >> 4;
    const int K = g.K, nt = K / BK;
    unsigned voffA[2], voffB[2];
#pragma unroll
    for (int i = 0; i < 2; ++i) { int R, C; stage_rc(tid * 16 + i * 8192, R, C); const int Rb = Epi::PERM ? ((R & ~31) + perm32(R & 31)) : R;
        voffA[i] = ATILED ? (unsigned)(R * 64 + C) * 2u : (unsigned)(R * K + C) * 2u; voffB[i] = (unsigned)(Rb * K + C) * 2u; }
    const size_t kstep = (size_t)(BK * 2);
    const size_t hstep = (size_t)HALF * K * 2;
    const size_t tstep = 2 * hstep;
    const size_t kstepA = ATILED ? (size_t)(256 * 64 * 2) : kstep, hstepA = ATILED ? (size_t)(HALF * 64 * 2) : hstep;
    const unsigned ldsw = (unsigned)wid * 1024u;
    const int aoff = lds_byte(wr * 64 + fr, fq * 8), boff = lds_byte(wc * 32 + fr, fq * 8);
#define PG8_SA(b, h) (((b) * 2 + (h)) * HTB)
#define PG8_SB(b, h) ((4 + (b) * 2 + (h)) * HTB)
#define PG8_STAGE(bufoff, gbase, voff) do { _Pragma("unroll") for (int _i = 0; _i < 2; ++_i) { unsigned vo_ = (voff)[_i]; \
        if constexpr (F8) { int R_, C_; stage_rc(opaque_i(tid) * 16 + _i * 8192, R_, C_); const bool isb_ = (&(voff)[0] == &voffB[0]); const int Rb_ = (isb_ && Epi::PERM) ? ((R_ & ~31) + perm32(R_ & 31)) : R_; vo_ = (unsigned)(Rb_ * K + C_) * 2u; } \
        __builtin_amdgcn_global_load_lds((const unsigned*)((const char*)(gbase) + vo_), (PG8_LAS unsigned*)(lds + (bufoff) + ldsw + _i * 8192), 16, 0, 0); } } while (0)
#define PG8_LDA(dst, b, h) do { _Pragma("unroll") for (int m = 0; m < 4; ++m) _Pragma("unroll") for (int k = 0; k < 2; ++k) dst[m][k] = *(const PG8_LAS bf16x8*)(lds + PG8_SA(b, h) + aoff + m * 2048 + k * 1024); } while (0)
#define PG8_LDB(dst, b, h) do { _Pragma("unroll") for (int n = 0; n < 2; ++n) _Pragma("unroll") for (int k = 0; k < 2; ++k) dst[n][k] = *(const PG8_LAS bf16x8*)(lds + PG8_SB(b, h) + boff + n * 2048 + k * 1024); } while (0)
#define PG8_MMA(ai, bj, At, Bt) do { __builtin_amdgcn_s_setprio(1); \
        if constexpr (F8) { _Pragma("unroll") for (int m = 0; m < 4; ++m) _Pragma("unroll") for (int n = 0; n < 2; ++n) \
            acc[ai][bj][m][n] = __builtin_amdgcn_mfma_scale_f32_16x16x128_f8f6f4(cat8(Bt[n][0], Bt[n][1]), cat8(At[m][0], At[m][1]), acc[ai][bj][m][n], 0, 0, 0, 0, 0, 0); } \
        else { _Pragma("unroll") for (int m = 0; m < 4; ++m) _Pragma("unroll") for (int n = 0; n < 2; ++n) _Pragma("unroll") for (int k = 0; k < 2; ++k) \
            acc[ai][bj][m][n] = __builtin_amdgcn_mfma_f32_16x16x32_bf16(Bt[n][k], At[m][k], acc[ai][bj][m][n], 0, 0, 0); } \
        __builtin_amdgcn_s_setprio(0); } while (0)
#define PG8_WAIT_V(n) asm volatile("s_waitcnt vmcnt(" #n ")" ::: "memory")
#define PG8_WAIT_L(n) asm volatile("s_waitcnt lgkmcnt(" #n ")" ::: "memory")
#define PG8_BAR __builtin_amdgcn_s_barrier()
#define PG8_SCHED __builtin_amdgcn_sched_barrier(0)
    Unit cur, nxt; int ui = 0;
    if (!S.next(0, cur)) return;
    f32x4 acc[2][2][4][2];
#pragma unroll
    for (int a = 0; a < 2; ++a)
#pragma unroll
        for (int b = 0; b < 2; ++b)
#pragma unroll
            for (int m = 0; m < 4; ++m)
#pragma unroll
                for (int n = 0; n < 2; ++n) acc[a][b][m][n] = (f32x4){0.f, 0.f, 0.f, 0.f};
    bf16x8 At[4][2], B0[2][2], B1[2][2];
    const char* cA = (const char*)g.A + (size_t)cur.pm * tstep; const char* cB = (const char*)g.Bt + (size_t)cur.pn * tstep;
    S.a_ready(cur);
    if constexpr (SP2) {
        PG8_STAGE(PG8_SB(0, 0), cB, voffB); PG8_STAGE(PG8_SB(0, 1), cB + hstep, voffB); PG8_STAGE(PG8_SA(0, 0), cA, voffA); PG8_STAGE(PG8_SA(0, 1), cA + hstepA, voffA);
        if (wr == 1) PG8_BAR;
        PG8_WAIT_V(2); PG8_BAR;
        PG8_STAGE(PG8_SB(1, 0), cB + kstep, voffB); PG8_STAGE(PG8_SA(1, 0), cA + kstepA, voffA); PG8_STAGE(PG8_SB(1, 1), cB + hstep + kstep, voffB);
        PG8_WAIT_V(6); PG8_BAR;
    } else {
        PG8_STAGE(PG8_SB(0, 0), cB, voffB); PG8_STAGE(PG8_SA(0, 0), cA, voffA); PG8_STAGE(PG8_SB(0, 1), cB + hstep, voffB); PG8_STAGE(PG8_SA(0, 1), cA + hstepA, voffA);
        if (wr == 1) PG8_BAR;
        PG8_WAIT_V(4); PG8_BAR;
        PG8_STAGE(PG8_SB(1, 0), cB + kstep, voffB); PG8_STAGE(PG8_SA(1, 0), cA + kstepA, voffA); PG8_STAGE(PG8_SB(1, 1), cB + hstep + kstep, voffB);
        PG8_WAIT_V(6); PG8_BAR;
    }
    for (;;) {
        const bool has_next = S.next(ui + 1, nxt);
        const char* nA = has_next ? (const char*)g.A + (size_t)nxt.pm * tstep : cA; const char* nB = has_next ? (const char*)g.Bt + (size_t)nxt.pn * tstep : cB;
#pragma clang loop unroll(disable)
        for (int t = 0; t < nt; t += 2) {
            const bool last = (t == nt - 2);
            const char* a1 = cA + (size_t)(t + 1) * kstepA;
            const char* a2 = last ? nA : cA + (size_t)(t + 2) * kstepA; const char* b2 = last ? nB : cB + (size_t)(t + 2) * kstep;
            const char* a3 = a2 + kstepA; const char* b3 = b2 + kstep;
            if (last && has_next) S.a_ready(nxt);
            if constexpr (SP2) {
            PG8_LDB(B0, 0, 0); PG8_LDB(B1, 0, 1); PG8_SCHED; PG8_LDA(At, 0, 0); PG8_STAGE(PG8_SA(1, 1), a1 + hstepA, voffA);
            PG8_WAIT_V(8); PG8_WAIT_L(0); PG8_BAR; PG8_MMA(0, 0, At, B0); PG8_MMA(0, 1, At, B1); PG8_BAR; PG8_SCHED;
            PG8_LDA(At, 0, 1); PG8_STAGE(PG8_SB(0, 0), b2, voffB); PG8_STAGE(PG8_SB(0, 1), b2 + hstep, voffB); PG8_STAGE(PG8_SA(0, 0), a2, voffA);
            PG8_WAIT_V(8); PG8_WAIT_L(0); PG8_BAR; PG8_MMA(1, 0, At, B0); PG8_MMA(1, 1, At, B1); PG8_BAR; PG8_SCHED;
            PG8_LDB(B0, 1, 0); PG8_LDB(B1, 1, 1); PG8_SCHED; PG8_LDA(At, 1, 0); PG8_STAGE(PG8_SA(0, 1), a2 + hstepA, voffA);
            PG8_WAIT_V(8); PG8_WAIT_L(0); PG8_BAR; PG8_MMA(0, 0, At, B0); PG8_MMA(0, 1, At, B1); PG8_BAR; PG8_SCHED;
            PG8_LDA(At, 1, 1); PG8_STAGE(PG8_SB(1, 0), b3, voffB); PG8_STAGE(PG8_SB(1, 1), b3 + hstep, voffB); PG8_STAGE(PG8_SA(1, 0), a3, voffA);
            PG8_WAIT_V(8); PG8_WAIT_L(0); PG8_BAR; PG8_MMA(1, 0, At, B0); PG8_MMA(1, 1, At, B1); PG8_BAR; PG8_SCHED;
            } else {
            PG8_LDB(B0, 0, 0); PG8_SCHED; PG8_LDA(At, 0, 0); PG8_STAGE(PG8_SA(1, 1), a1 + hstepA, voffA);
            PG8_WAIT_L(8); PG8_BAR; PG8_WAIT_L(0); PG8_MMA(0, 0, At, B0); PG8_BAR; PG8_SCHED;
            PG8_LDB(B1, 0, 1); PG8_STAGE(PG8_SB(0, 0), b2, voffB);
            PG8_BAR; PG8_WAIT_L(0); PG8_MMA(0, 1, At, B1); PG8_BAR;
            PG8_LDA(At, 0, 1); PG8_STAGE(PG8_SA(0, 0), a2, voffA);
            PG8_BAR; PG8_WAIT_L(0); PG8_MMA(1, 0, At, B0); PG8_BAR; PG8_SCHED;
            PG8_STAGE(PG8_SB(0, 1), b2 + hstep, voffB);
            PG8_WAIT_V(6); PG8_BAR; PG8_MMA(1, 1, At, B1); PG8_BAR;
            PG8_LDB(B0, 1, 0); PG8_SCHED; PG8_LDA(At, 1, 0); PG8_STAGE(PG8_SA(0, 1), a2 + hstepA, voffA);
            PG8_WAIT_L(8); PG8_BAR; PG8_WAIT_L(0); PG8_MMA(0, 0, At, B0); PG8_BAR; PG8_SCHED;
            PG8_LDB(B1, 1, 1); PG8_STAGE(PG8_SB(1, 0), b3, voffB);
            PG8_BAR; PG8_WAIT_L(0); PG8_MMA(0, 1, At, B1); PG8_BAR;
            PG8_LDA(At, 1, 1); PG8_STAGE(PG8_SA(1, 0), a3, voffA);
            PG8_BAR; PG8_WAIT_L(0); PG8_MMA(1, 0, At, B0); PG8_BAR; PG8_SCHED;
            PG8_STAGE(PG8_SB(1, 1), b3 + hstep, voffB);
            PG8_WAIT_V(6); PG8_BAR; PG8_MMA(1, 1, At, B1); PG8_BAR;
            }
            if constexpr (Epi::HAS_MID) { if (t == nt / 2 - 2) E.mid(acc, cur, wr, wc, fr, fq); }
        }
        if constexpr (ALIGN_EPI) { if (wr == 0) PG8_BAR; }
        E(acc, cur, wr, wc, fr, fq);
        if (!has_next) break;
#pragma unroll
        for (int a = 0; a < 2; ++a)
#pragma unroll
            for (int b = 0; b < 2; ++b)
#pragma unroll
                for (int m = 0; m < 4; ++m)
#pragma unroll
                    for (int n = 0; n < 2; ++n) acc[a][b][m][n] = (f32x4){0.f, 0.f, 0.f, 0.f};
        cur = nxt; cA = nA; cB = nB; ++ui;
        if constexpr (ALIGN_EPI) { if (wr == 1) PG8_BAR; }
    }
    PG8_WAIT_V(0);
    if constexpr (!ALIGN_EPI) { if (wr == 0) PG8_BAR; }
    PG8_BAR;
#undef PG8_SA
#undef PG8_SB
#undef PG8_STAGE
#undef PG8_LDA
#undef PG8_LDB
#undef PG8_MMA
#undef PG8_WAIT_V
#undef PG8_WAIT_L
#undef PG8_BAR
#undef PG8_SCHED
}
}
constexpr int RING_OFF = 0, RING_BYTES = 131072;
constexpr int LDSCTL_OFF = RING_BYTES, MISC_OFF = LDSCTL_OFF + 320;
constexpr int RSTD_LDS_OFF = 135168, LDS_BYTES = 155648;

#define GAS __attribute__((address_space(1)))
#define LAS __attribute__((address_space(3)))
typedef unsigned short bf16;
typedef unsigned v4u __attribute__((ext_vector_type(4)));
typedef unsigned v2u __attribute__((ext_vector_type(2)));
typedef float f32x4 __attribute__((ext_vector_type(4)));
typedef float f32x16 __attribute__((ext_vector_type(16)));
typedef short bf16x8 __attribute__((ext_vector_type(8)));
typedef GAS unsigned gu32;
#define RLX_AGENT __ATOMIC_RELAXED, __HIP_MEMORY_SCOPE_AGENT
#define LDS_WAIT() asm volatile("s_waitcnt lgkmcnt(0)" ::: "memory")
#define VM_WAIT() asm volatile("s_waitcnt vmcnt(0)" ::: "memory")
typedef float f32x2_t __attribute__((ext_vector_type(2))); typedef __bf16 bf16x2_t __attribute__((ext_vector_type(2)));
__device__ __forceinline__ unsigned pk2(float lo, float hi) { f32x2_t v = {lo, hi}; bf16x2_t b = __builtin_convertvector(v, bf16x2_t); return __builtin_bit_cast(unsigned, b); }
__device__ __forceinline__ float bf2f(bf16 v) { return __uint_as_float((unsigned)v << 16); }
__device__ __forceinline__ bf16 f2bf(float f) { return (bf16)(pk2(f, 0.f) & 0xffffu); }
__device__ __forceinline__ int pi32(int r) { return (r & ~12) | ((r & 4) << 1) | ((r & 8) >> 1); }
__device__ __forceinline__ int crow(int r, int hi) { return (r & 3) + 8 * (r >> 2) + 4 * hi; }
__device__ __forceinline__ float wave_sum(float v) {
#pragma unroll
    for (int o = 1; o < 64; o <<= 1) v += __shfl_xor(v, o);
    return v;
}
__device__ __forceinline__ float wave_max(float v) {
#pragma unroll
    for (int o = 1; o < 64; o <<= 1) v = fmaxf(v, __shfl_xor(v, o));
    return v;
}
__device__ __forceinline__ bf16x8 pack_frag(float a0, float a1, float a2, float a3, float a4, float a5, float a6, float a7) {
    v4u w; w.x = pk2(a0, a1); w.y = pk2(a2, a3); w.z = pk2(a4, a5); w.w = pk2(a6, a7); return __builtin_bit_cast(bf16x8, w);
}
#define MFMA32(a, b, c) __builtin_amdgcn_mfma_f32_32x32x16_bf16((a), (b), (c), 0, 0, 0)

#define XB_TMO      128
#define XB_XCNT(j)  (256  + 64 * (j))
#define XB_XSUB(j)  (1280 + 64 * (j))
#define XB_XGEN(j)  (2304 + 64 * (j))
#define XB_TOP      3328
#define XB_TOPGEN   3392
#define XCD_BAR_WORDS 3456
#define XB_SPIN_CAP (1u << 18)

__device__ __forceinline__ unsigned xb_ld(unsigned* p)              { return __hip_atomic_load(p, __ATOMIC_RELAXED, __HIP_MEMORY_SCOPE_AGENT); }
__device__ __forceinline__ unsigned xb_add(unsigned* p, unsigned v) { return __hip_atomic_fetch_add(p, v, __ATOMIC_RELAXED, __HIP_MEMORY_SCOPE_AGENT); }
__device__ __forceinline__ unsigned xb_xcc_id() { return (unsigned)__builtin_amdgcn_s_getreg((3 << 11) | 20) & 0xFu; }
#define XB_SPIN(cond, bar) do { unsigned _sp = 0; while (cond) { __builtin_amdgcn_s_sleep(1); \
    if ((++_sp & 255u) == 0u) { if (xb_ld(&(bar)[XB_TMO])) break; if (_sp > XB_SPIN_CAP) { atomicAdd(&(bar)[XB_TMO], 1u); break; } } } } while (0)

struct XcdBarrier {
    unsigned* bar; unsigned x;
    volatile LAS unsigned* st;
};

__device__ __forceinline__ XcdBarrier xcd_barrier_post(unsigned* bar, volatile LAS unsigned* st) {
    XcdBarrier b; b.bar = bar; b.x = xb_xcc_id(); b.st = st;
    if (threadIdx.x == 0) (void)xb_add(&bar[XB_XCNT(b.x)], 1u);
    return b;
}
__device__ __forceinline__ void xcd_barrier_complete(unsigned* bar, unsigned x, unsigned& nloc, unsigned& nx) {
    const unsigned G = gridDim.x * gridDim.y * gridDim.z;
    unsigned sum, cnt, mine, sp = 0u;
    for (;;) {
        sum = 0u; cnt = 0u; mine = 0u;
#pragma unroll
        for (unsigned j = 0; j < 16; ++j) { const unsigned c = xb_ld(&bar[XB_XCNT(j)]); sum += c; cnt += (c > 0u) ? 1u : 0u; mine = (j == x) ? c : mine; }
        if (sum == G) break;
        __builtin_amdgcn_s_sleep(1);
        if ((++sp & 255u) == 0u) { if (xb_ld(&bar[XB_TMO])) break; if (sp > XB_SPIN_CAP) { atomicAdd(&bar[XB_TMO], 1u); break; } }
    }
    nloc = mine > 0u ? mine : 1u; nx = cnt > 0u ? cnt : 1u;
}

__device__ __forceinline__ void xcd_barrier(const XcdBarrier& b, bool release = true) {
    asm volatile("s_waitcnt vmcnt(0)" ::: "memory");
    __syncthreads();
    if (threadIdx.x == 0) {
        unsigned* bar = b.bar;
        __builtin_amdgcn_s_waitcnt(0);
        unsigned nloc = b.st[0], nx = b.st[1];
        if (nloc == 0u) { xcd_barrier_complete(bar, b.x, nloc, nx); b.st[0] = nloc; b.st[1] = nx; }
        const unsigned old = xb_add(&bar[XB_XSUB(b.x)], 1u);
        const unsigned gen = old / nloc;
        if (old + 1u == (gen + 1u) * nloc) {
            if (release) __builtin_amdgcn_fence(__ATOMIC_RELEASE, "agent");
            asm volatile("s_waitcnt vmcnt(0)" ::: "memory");
            if (release) {
            const unsigned og = xb_add(&bar[XB_TOP], 1u);
            const unsigned tg = og / nx;
            if (og + 1u == (tg + 1u) * nx) xb_add(&bar[XB_TOPGEN], 1u);
            else XB_SPIN(xb_ld(&bar[XB_TOPGEN]) == tg, bar);
            }
            __builtin_amdgcn_fence(__ATOMIC_ACQUIRE, "agent");
            xb_add(&bar[XB_XGEN(b.x)], 1u);
            asm volatile("s_waitcnt vmcnt(0)" ::: "memory");
        } else {
            XB_SPIN(xb_ld(&bar[XB_XGEN(b.x)]) == gen, bar);
            __builtin_amdgcn_fence(__ATOMIC_ACQUIRE, "agent");
            asm volatile("s_waitcnt vmcnt(0)" ::: "memory");
        }
    }
    __syncthreads();
}


__device__ __forceinline__ void head_group_sync(unsigned* cnt, unsigned* tmo, unsigned target = 8u) {
    asm volatile("s_waitcnt vmcnt(0)" ::: "memory");
    __syncthreads();
    if (threadIdx.x == 0) {
        __hip_atomic_fetch_add(cnt, 1u, __ATOMIC_RELAXED, __HIP_MEMORY_SCOPE_AGENT);
        unsigned sp = 0; while (xb_ld(cnt) < target) { __builtin_amdgcn_s_sleep(1); if ((++sp & 255u) == 0u) { if (xb_ld(tmo)) break; if (sp > XB_SPIN_CAP) { atomicAdd(tmo, 1u); break; } } }
        __builtin_amdgcn_fence(__ATOMIC_ACQUIRE, "agent");
        asm volatile("s_waitcnt vmcnt(0)" ::: "memory");
    }
    __syncthreads();
}

struct Args {
    const float* x; const float* norm_mix; const float* w_in; const float* a_q_norm; const float* a_k_norm; const float* lq1; const float* lk1; const float* lq2; const float* lk2;
    const float* a_sub_norm; const float* b_gate_up; const float* b_gate_bias; const float* b_out_norm; const float* w_branch; const float* w_out; const float* norm_ffn; const float* w_up; const float* w_down;
    float* out; unsigned char* ws; float lam_init[4]; int ph_lo, ph_hi;
};
struct Frame {
    LAS unsigned char* lds; unsigned char* ldsg;
    int tid, lane, wave;
    int x, r, nl, xr;
};
__device__ __forceinline__ Frame make_frame(unsigned char* lds) {
    Frame F; F.lds = (LAS unsigned char*)lds; F.ldsg = lds;
    F.tid = pg8::opaque_i(threadIdx.x); F.lane = F.tid & 63; F.wave = __builtin_amdgcn_readfirstlane(F.tid >> 6);
    const volatile LAS unsigned* M = (const volatile LAS unsigned*)(F.lds + pg8::opaque_i(MISC_OFF));
    F.xr = __builtin_amdgcn_readfirstlane((int)M[16]); F.x = 0; F.r = __builtin_amdgcn_readfirstlane((int)M[17]); F.nl = __builtin_amdgcn_readfirstlane((int)M[18]);
    return F;
}
template <int NN, bool TMODE, int SKIP = 1 << 20> struct XcdOrder {
    int x, r, nl;
    __device__ __forceinline__ bool next(int i, pg8::Unit& u) const {
        const int k = r + i * nl;
        if (!TMODE) { if (k >= 16 * NN) return false; const int g = k / (8 * NN), rem = k - g * (8 * NN); u.pm = 16 * x + 8 * g + (rem & 7); u.pn = rem >> 3; if (u.pn >= SKIP) ++u.pn; }
        else { if (k >= 16 * NN) return false; const int g = k / (8 * NN), rem = k - g * (8 * NN); u.pn = 16 * x + 8 * g + (rem & 7); u.pm = rem >> 3; }
        return true;
    }
    __device__ __forceinline__ void a_ready(const pg8::Unit&) const {}
    __device__ __forceinline__ void done(const pg8::Unit&) const {}
};

__device__ __forceinline__ void conv_store(LAS float* scr, bf16* WT, int ldt, int row0, int k0, int lane) {
    LDS_WAIT(); asm volatile("" ::: "memory");
    const int c = lane & 7;
#pragma unroll
    for (int j = 0; j < 4; ++j) { const int n = (lane >> 3) + 8 * j; const LAS float* s = scr + (8 * c) * 33 + n;
        v4u o; o.x = pk2(s[0 * 33], s[1 * 33]); o.y = pk2(s[2 * 33], s[3 * 33]); o.z = pk2(s[4 * 33], s[5 * 33]); o.w = pk2(s[6 * 33], s[7 * 33]);
        *(GAS v4u*)(WT + (size_t)(row0 + n) * ldt + k0 + 8 * c) = o; }
    LDS_WAIT(); asm volatile("" ::: "memory");
}
__device__ __forceinline__ void conv_item8(const float* W, int ldw, int col0, int k0, const float* gain, unsigned char* W8, int row0, LAS float* scr, int lane) {
    f32x4 v[8]; float gk[8]; const int kq = lane >> 3, n4 = (lane & 7) * 4;
#pragma unroll
    for (int i = 0; i < 8; ++i) { const int kk = kq + 8 * i; v[i] = *(const f32x4*)(W + (size_t)(k0 + kk) * ldw + col0 + n4); gk[i] = gain[k0 + kk] * 32.0f; }
#pragma unroll
    for (int i = 0; i < 8; ++i) { const int kk = kq + 8 * i; LAS float* s = scr + kk * 33 + n4; s[0] = v[i][0] * gk[i]; s[1] = v[i][1] * gk[i]; s[2] = v[i][2] * gk[i]; s[3] = v[i][3] * gk[i]; }
    LDS_WAIT(); asm volatile("" ::: "memory");
    const int c = lane & 7;
#pragma unroll
    for (int j = 0; j < 4; ++j) { const int n = (lane >> 3) + 8 * j; const LAS float* s = scr + (8 * c) * 33 + n;
        v2u o; o.x = pg8::pk4_fp8((f32x4){s[0 * 33], s[1 * 33], s[2 * 33], s[3 * 33]}); o.y = pg8::pk4_fp8((f32x4){s[4 * 33], s[5 * 33], s[6 * 33], s[7 * 33]});
        *(GAS v2u*)(W8 + (size_t)(row0 + n) * DM + k0 + 8 * c) = o; }
    LDS_WAIT(); asm volatile("" ::: "memory");
}
__device__ __forceinline__ void conv_item(const float* W, int ldw, int col0, int k0, const float* gain, bf16* WT, int ldt, int row0, LAS float* scr, int lane) {
    f32x4 v[8]; float gk[8]; const int kq = lane >> 3, n4 = (lane & 7) * 4;
#pragma unroll
    for (int i = 0; i < 8; ++i) { const int kk = kq + 8 * i; v[i] = *(const f32x4*)(W + (size_t)(k0 + kk) * ldw + col0 + n4); gk[i] = gain ? gain[k0 + kk] : 1.f; }
#pragma unroll
    for (int i = 0; i < 8; ++i) { const int kk = kq + 8 * i; LAS float* s = scr + kk * 33 + n4; s[0] = v[i][0] * gk[i]; s[1] = v[i][1] * gk[i]; s[2] = v[i][2] * gk[i]; s[3] = v[i][3] * gk[i]; }
    conv_store(scr, WT, ldt, row0, k0, lane);
}
__device__ __forceinline__ void conv_item_z(const float* Win, const float* Wgu, int c0, int k0, const float* gain, bf16* WT, int row0, LAS float* scr, int lane) {
    float gu[16];
#pragma unroll
    for (int r = 0; r < 16; ++r) gu[r] = Wgu[r * 256 + c0 + (lane & 31)];
#pragma unroll 4
    for (int i = 0; i < 32; ++i) { const int kk = 2 * i + (lane >> 5); const float* wr_ = Win + (size_t)(k0 + kk) * DIN + C_BA; float v = 0.f;
#pragma unroll
        for (int r = 0; r < 16; ++r) v += wr_[r] * gu[r];
        scr[kk * 33 + (lane & 31)] = v * gain[k0 + kk]; }
    conv_store(scr, WT, DM, row0, k0, lane);
}
__device__ __forceinline__ void conv_item_z8(const float* Win, const float* Wgu, int c0, int k0, const float* gain, unsigned char* W8, int row0, LAS float* scr, int lane) {
    float gu[16];
#pragma unroll
    for (int r = 0; r < 16; ++r) gu[r] = Wgu[r * 256 + c0 + (lane & 31)];
#pragma unroll 4
    for (int i = 0; i < 32; ++i) { const int kk = 2 * i + (lane >> 5); const float* wr_ = Win + (size_t)(k0 + kk) * DIN + C_BA; float v = 0.f;
#pragma unroll
        for (int r = 0; r < 16; ++r) v += wr_[r] * gu[r];
        scr[kk * 33 + (lane & 31)] = v * gain[k0 + kk] * 32.0f; }
    LDS_WAIT(); asm volatile("" ::: "memory");
    const int c = lane & 7;
#pragma unroll
    for (int j = 0; j < 4; ++j) { const int n = (lane >> 3) + 8 * j; const LAS float* s = scr + (8 * c) * 33 + n;
        v2u o; o.x = pg8::pk4_fp8((f32x4){s[0 * 33], s[1 * 33], s[2 * 33], s[3 * 33]}); o.y = pg8::pk4_fp8((f32x4){s[4 * 33], s[5 * 33], s[6 * 33], s[7 * 33]});
        *(GAS v2u*)(W8 + (size_t)(row0 + n) * DM + k0 + 8 * c) = o; }
    LDS_WAIT(); asm volatile("" ::: "memory");
}
__device__ __forceinline__ void p0_weights(Frame& F, const Args& a) {
    const int gw = (int)blockIdx.x * NWAVES + F.wave, NGW = (int)gridDim.x * NWAVES;
    if (blockIdx.x < DEPTH && F.wave == 0) {
        const int l = blockIdx.x; float* par = (float*)(a.ws + WS_PAR + (size_t)l * PAR_LAYER_BYTES); const int lane = F.lane;
        par[PAR_QG + lane] = a.a_q_norm[l * 64 + lane]; par[PAR_KG + lane] = a.a_k_norm[l * 64 + lane];
#pragma unroll
        for (int i = 0; i < 4; ++i) par[PAR_ZB + 64 * i + lane] = a.b_gate_bias[l * 256 + 64 * i + lane];
#pragma unroll
        for (int i = 0; i < 2; ++i) { par[PAR_SUB + 64 * i + lane] = a.a_sub_norm[l * 128 + 64 * i + lane]; par[PAR_OUTG + 64 * i + lane] = a.b_out_norm[l * 128 + 64 * i + lane]; }
        const float p1 = wave_sum(a.lq1[l * 64 + lane] * a.lk1[l * 64 + lane]), p2 = wave_sum(a.lq2[l * 64 + lane] * a.lk2[l * 64 + lane]);
        const float gq = wave_max(fabsf(a.a_q_norm[l * 64 + lane])), gk = wave_max(fabsf(a.a_k_norm[l * 64 + lane]));
        if (lane == 0) { par[PAR_LAM] = __expf(p1) - __expf(p2) + a.lam_init[l]; par[PAR_NEGB] = -(64.f * gq * gk * 0.125f * 1.4426950408889634f); par[PAR_ONEM] = 1.f - a.lam_init[l]; }
    }
    LAS float* scr = (LAS float*)(F.lds + RING_OFF + F.wave * 16384);
    constexpr int I_N = (NIN_N / 32) * 16, I_T = (NIN_T / 32) * 16, I_BR = 32 * 16, I_OUT = 32 * 16, I_UP = 128 * 16, I_DN = 32 * 64;
    constexpr int NITEMS = I_N + I_T + I_BR + I_OUT + I_UP + I_DN;
    for (int itg = gw; itg < DEPTH * NITEMS; itg += NGW) {
        const int l = itg / NITEMS; int r = itg - l * NITEMS; const int lane_ = pg8::opaque_i(F.lane);
        const float* Win = a.w_in + (size_t)l * DM * DIN; const float* gmix = a.norm_mix + l * DM; const float* Wgu = a.b_gate_up + (size_t)l * 16 * 256;
        unsigned char* wl = a.ws + WS_W0 + (size_t)l * W_LAYER; bf16* WN = (bf16*)(wl + WO_IN_N); bf16* WTt = (bf16*)(wl + WO_IN_T);
        if (r < I_N) { const int nb = r % (NIN_N / 32), kb = r / (NIN_N / 32), tile = nb >> 3, jb = nb & 7, foff = 64 * (jb & 3) + 32 * (jb >> 2), row0 = tile * 256 + 32 * jb;
            if (tile == 6) { conv_item_z8(Win, Wgu, foff, kb * 64, gmix, wl + WO_IN_G8, 8 * 256 + 32 * jb, scr, lane_); continue; }
            const int col0 = (tile < 2 ? C_AQ + tile * 256 : tile < 4 ? C_AK + (tile - 2) * 256 : tile == 4 ? C_BQ : tile == 5 ? C_BK : tile < 9 ? C_BR + (tile - 7) * 256 : C_GT + (tile - 9) * 256) + foff;
            if (tile >= 9) { conv_item8(Win, DIN, col0, kb * 64, gmix, wl + WO_IN_G8, row0 - 9 * 256, scr, lane_); continue; }
            conv_item(Win, DIN, col0, kb * 64, gmix, WN, DM, row0, scr, lane_); continue; }
        r -= I_N;
        if (r < I_T) { const int rb = r % (NIN_T / 32), kb = r / (NIN_T / 32), f0 = rb * 32;
            const int col0 = f0 < 512 ? C_AV + f0 : C_BV + (f0 - 512);
            conv_item(Win, DIN, col0, kb * 64, gmix, WTt, DM, f0, scr, lane_); continue; }
        r -= I_T;
        if (r < I_BR) { conv_item(a.w_branch + (size_t)l * DM * DM, DM, (r & 31) * 32, (r >> 5) * 64, nullptr, (bf16*)(wl + WO_BR), DM, (r & 31) * 32, scr, lane_); continue; }
        r -= I_BR;
        if (r < I_OUT) { conv_item(a.w_out + (size_t)l * DM * DM, DM, (r & 31) * 32, (r >> 5) * 64, nullptr, (bf16*)(wl + WO_OUT), DM, (r & 31) * 32, scr, lane_); continue; }
        r -= I_OUT;
        if (r < I_UP) { conv_item(a.w_up + (size_t)l * DM * DFF, DFF, (r & 127) * 32, (r >> 7) * 64, a.norm_ffn + l * DM, (bf16*)(wl + WO_UP), DM, (r & 127) * 32, scr, lane_); continue; }
        r -= I_UP;
        conv_item(a.w_down + (size_t)l * DFF * DM, DM, (r & 31) * 32, (r >> 5) * 64, nullptr, (bf16*)(wl + WO_DN), DFF, (r & 31) * 32, scr, lane_);
    }
}
__device__ __forceinline__ void p0_x(Frame& F, const Args& a, unsigned char* wsb, unsigned char* x8) {
    float* part = (float*)(wsb + WS_PARTA); bf16* XB = (bf16*)(wsb + WS_XB);
    for (int k = 2 * (F.r * NWAVES + F.wave); k < SEQ; k += 2 * F.nl * NWAVES) {
        const GAS f32x4* xr = (const GAS f32x4*)(a.x + (size_t)(F.xr * SEQ + k) * DM) + F.lane; f32x4 v[2][4]; float s[2] = {0.f, 0.f};
#pragma unroll
        for (int q = 0; q < 2; ++q)
#pragma unroll
            for (int j = 0; j < 4; ++j) v[q][j] = xr[q * (DM / 4) + 64 * j];
#pragma unroll
        for (int q = 0; q < 2; ++q) {
#pragma unroll
            for (int j = 0; j < 4; ++j) s[q] += (v[q][j].x * v[q][j].x + v[q][j].y * v[q][j].y) + (v[q][j].z * v[q][j].z + v[q][j].w * v[q][j].w);
            s[q] = wave_sum(s[q]);
            GAS v2u* o8 = (GAS v2u*)(XB + (size_t)(k + q) * DM) + F.lane;
#pragma unroll
            for (int j = 0; j < 4; ++j) { v2u w; w.x = pk2(v[q][j].x, v[q][j].y); w.y = pk2(v[q][j].z, v[q][j].w); o8[64 * j] = w; }
            GAS unsigned* o4 = (GAS unsigned*)(x8 + (size_t)(k + q) * DM) + F.lane;
#pragma unroll
            for (int j = 0; j < 4; ++j) o4[64 * j] = pg8::pk4_fp8(v[q][j]);
            if (F.lane < 4) *(f32x4*)(part + (size_t)(k + q) * 16 + 4 * F.lane) = (f32x4){F.lane == 0 ? s[q] : 0.f, 0.f, 0.f, 0.f};
        }
    }
}
__device__ __forceinline__ void fill_rstd_lds(Frame& F, const float* part) {
    LAS float* tbl = (LAS float*)(F.lds + RSTD_LDS_OFF);
    if (F.nl == 32) {
        const int k = ((F.tid >> 8) * 8 + (F.r & 7)) * 256 + (F.tid & 255);
        tbl[k] = rsqrtf(pg8::sum16(part + (size_t)(F.x * SEQ + k) * 16) * (1.0f / 1024.0f) + pg8::RMS_EPS);
    } else {
#pragma unroll 2
        for (int k = F.tid; k < SEQ; k += NWAVES * 64) tbl[k] = rsqrtf(pg8::sum16(part + (size_t)(F.x * SEQ + k) * 16) * (1.0f / 1024.0f) + pg8::RMS_EPS);
    }
    __syncthreads();
}

constexpr int AT_SLOT = 32768, AT_K2 = 8192, AT_V = 16384;
__device__ __forceinline__ void attn_phase(Frame& F, unsigned char* ws, const float* par, bf16* Y) {
    const bf16* Qa = (const bf16*)(ws + WS_QA); const bf16* Ka = (const bf16*)(ws + WS_KA); const bf16* Vta = (const bf16*)(ws + WS_VTA);
    const int lane = F.lane, r = lane & 31, hh = lane >> 5, w = F.wave, m = w >> 2, qs = w & 3;
    const float lam = par[PAR_LAM], negb = par[PAR_NEGB], onem = par[PAR_ONEM];
    LAS unsigned char* const L = F.lds;
    float* X = (float*)(F.ldsg);
    float* lw = (float*)(F.ldsg + 65536 + w * 128);
    bf16* stg = (bf16*)(F.ldsg + 69632 + (w & 3) * 8192);
    const int i8 = lane >> 3, i7 = lane & 7;
    const int koff = (8 * w + i8) * 512 + ((i7 ^ ((4 * w + (lane >> 4)) & 7)) * 8);
    const int voff0 = (16 * w + i8) * 64 + ((i7 ^ ((8 * w + (lane >> 4)) & 7)) * 8), voff1 = (16 * w + 8 + i8) * 64 + ((i7 ^ ((8 * w + 4 + (lane >> 4)) & 7)) * 8);
    const int rowK = pi32(r), kx = (rowK >> 1) & 7, vx = (r >> 1) & 7;
    int kfo[4], vfo[4];
#pragma unroll
    for (int j = 0; j < 4; ++j) { kfo[j] = m * AT_K2 + rowK * 128 + (((2 * j + hh) ^ kx) * 16); vfo[j] = AT_V + r * 128 + (((2 * j + hh) ^ vx) * 16); }
    if (w >= 4) __builtin_amdgcn_s_setprio(1);
    for (int ui = F.r; ui < 128; ui += F.nl) {
        const int h = ui >> 5, rr = ui & 31, r2 = (rr + 16) & 31, qblk = h == 0 ? rr : h == 1 ? 31 - rr : h == 2 ? r2 : 31 - r2, b = F.x, bh = b * 4 + h;
        const int q0 = qblk * 128 + 32 * qs, NT = 2 * qblk + 2, mynt = qs < 2 ? NT - 1 : NT; const size_t tb = (size_t)b * SEQ;
        const bf16* kbase = Ka + tb * 512 + h * 128 + koff;
        const bf16* vbase = Vta + (size_t)(bh * 64) * 8192;
#define AT_DMA(kt, slot) do { const bf16* kp_ = kbase + (size_t)(kt) * (64 * 512); const bf16* vp_ = vbase + (size_t)(kt) * 8192; LAS unsigned char* sl_ = L + (slot) * AT_SLOT + w * 1024; \
        __builtin_amdgcn_global_load_lds((const unsigned*)kp_, (LAS unsigned*)sl_, 16, 0, 0); __builtin_amdgcn_global_load_lds((const unsigned*)(kp_ + 64), (LAS unsigned*)(sl_ + AT_K2), 16, 0, 0); \
        __builtin_amdgcn_global_load_lds((const unsigned*)(vp_ + voff0), (LAS unsigned*)(sl_ + AT_V + w * 1024), 16, 0, 0); __builtin_amdgcn_global_load_lds((const unsigned*)(vp_ + voff1), (LAS unsigned*)(sl_ + AT_V + w * 1024 + 1024), 16, 0, 0); } while (0)
        AT_DMA(0, 0); AT_DMA(1, 1);
        bf16x8 qf[4];
#pragma unroll
        for (int d0 = 0; d0 < 4; ++d0) qf[d0] = *(const bf16x8*)(Qa + (tb + q0 + r) * 512 + h * 128 + m * 64 + 16 * d0 + 8 * hh);
        f32x16 o[4]; float lsum = 0.f;
#pragma unroll
        for (int eb = 0; eb < 4; ++eb)
#pragma unroll
            for (int i = 0; i < 16; ++i) o[eb][i] = 0.f;
        int slot = 0;
        for (int t = 0; t < NT; ++t) {
            if (t + 1 < NT) asm volatile("s_waitcnt vmcnt(4)" ::: "memory"); else asm volatile("s_waitcnt vmcnt(0)" ::: "memory");
            __builtin_amdgcn_s_barrier(); asm volatile("" ::: "memory");
            if (t + 2 < NT) { const int s2 = slot == 0 ? 2 : slot - 1; AT_DMA(t + 2, s2); }
            if (t < mynt) {
                LAS unsigned char* const sl = L + slot * AT_SLOT;
                f32x16 p[2];
                bf16x8 kfa[4], kfb[4];
#pragma unroll
                for (int d0 = 0; d0 < 4; ++d0) kfa[d0] = *(const LAS bf16x8*)(sl + kfo[d0]);
#pragma unroll
                for (int d0 = 0; d0 < 4; ++d0) kfb[d0] = *(const LAS bf16x8*)(sl + 4096 + kfo[d0]);
#pragma unroll
                for (int i = 0; i < 16; ++i) { p[0][i] = negb; p[1][i] = negb; }
                __builtin_amdgcn_sched_barrier(0);
#pragma unroll
                for (int d0 = 0; d0 < 4; ++d0) p[0] = MFMA32(kfa[d0], qf[d0], p[0]);
#pragma unroll
                for (int d0 = 0; d0 < 4; ++d0) p[1] = MFMA32(kfb[d0], qf[d0], p[1]);
#pragma unroll
                for (int kb = 0; kb < 2; ++kb)
#pragma unroll
                    for (int i = 0; i < 16; ++i) { p[kb][i] = __builtin_amdgcn_exp2f(p[kb][i]); lsum += p[kb][i]; }
#pragma unroll
                for (int kb = 0; kb < 2; ++kb)
#pragma unroll
                    for (int sg = 0; sg < 2; ++sg) {
                        bf16x8 vf[4];
#pragma unroll
                        for (int eb = 0; eb < 4; ++eb) vf[eb] = *(const LAS bf16x8*)(sl + eb * 4096 + vfo[2 * kb + sg]);
                        const bf16x8 pf = pack_frag(p[kb][8 * sg], p[kb][8 * sg + 1], p[kb][8 * sg + 2], p[kb][8 * sg + 3], p[kb][8 * sg + 4], p[kb][8 * sg + 5], p[kb][8 * sg + 6], p[kb][8 * sg + 7]);
#pragma unroll
                        for (int eb = 0; eb < 4; ++eb) o[eb] = MFMA32(pf, vf[eb], o[eb]);
                    }
            }
            slot = slot == 2 ? 0 : slot + 1;
        }
#undef AT_DMA
        asm volatile("s_waitcnt lgkmcnt(0)" ::: "memory"); __builtin_amdgcn_s_barrier(); asm volatile("" ::: "memory");
        lsum += __shfl_xor(lsum, 32);
        if (hh == 0) lw[r] = lsum;
        LDS_WAIT(); asm volatile("" ::: "memory");
        float inv[16];
#pragma unroll
        for (int i = 0; i < 16; ++i) inv[i] = 1.f / lw[crow(i, hh)];
        if (m == 1) {
#pragma unroll
            for (int eb = 0; eb < 4; ++eb)
#pragma unroll
                for (int i = 0; i < 16; ++i) X[((qs * 4 + eb) * 16 + i) * 64 + lane] = lam * o[eb][i] * inv[i];
        }
        __syncthreads();
        if (m == 0) {
            float ss[16];
#pragma unroll
            for (int i = 0; i < 16; ++i) ss[i] = 0.f;
#pragma unroll
            for (int eb = 0; eb < 4; ++eb)
#pragma unroll
                for (int i = 0; i < 16; ++i) { const float val = o[eb][i] * inv[i] - X[((qs * 4 + eb) * 16 + i) * 64 + lane]; o[eb][i] = val; ss[i] += val * val; }
#pragma unroll
            for (int of = 1; of < 32; of <<= 1) { float t[16];
#pragma unroll
                for (int i = 0; i < 16; ++i) t[i] = __shfl_xor(ss[i], of);
#pragma unroll
                for (int i = 0; i < 16; ++i) ss[i] += t[i]; }
#pragma unroll
            for (int i = 0; i < 16; ++i) ss[i] = rsqrtf(ss[i] * (1.0f / 128.0f) + pg8::RMS_EPS) * onem;
#pragma unroll
            for (int eb = 0; eb < 4; ++eb) { const float g = par[PAR_SUB + 32 * eb + r];
#pragma unroll
                for (int i = 0; i < 16; ++i) stg[crow(i, hh) * 128 + 32 * eb + r] = f2bf(o[eb][i] * ss[i] * g); }
            LDS_WAIT(); asm volatile("" ::: "memory");
            const int lane2 = pg8::opaque_i(lane);
#pragma unroll
            for (int jj = 0; jj < 8; ++jj) { const int row = (jj * 64 + lane2) >> 4, ch = lane2 & 15; const v4u vv = *(const v4u*)(stg + row * 128 + ch * 8);
                *(v4u*)(Y + (tb + q0 + row) * 1024 + h * 128 + ch * 8) = vv; }
        }
        __syncthreads();
    }
    __builtin_amdgcn_s_setprio(0);
}

__device__ __forceinline__ void gla_kv_phase(Frame& F, unsigned char* ws, unsigned char* kvbuf) {
    const bf16* Vtb = (const bf16*)(ws + WS_VTB); const bf16* Ktb = (const bf16*)(ws + WS_KTB); const bf16* Gtt = (const bf16*)(ws + WS_GTT);
    v2u* KV = (v2u*)kvbuf; float* DEC = (float*)(ws + WS_DEC);
    const int lane = F.lane, r = lane & 31, hh = lane >> 5;
    const bool grouped = F.nl == 32;
    for (int itl = (grouped ? (F.r & 7) : F.r) * NWAVES + F.wave; itl < (grouped ? 128 : NCH * 4 * 2); itl += (grouped ? 8 : F.nl) * NWAVES) {
        const int b = F.x, it = grouped ? (((itl >> 1) << 3) | ((F.r >> 3) << 1) | (itl & 1)) : b * 512 + itl, eh = it & 1, h = (it >> 1) & 3, n = (it >> 3) & 63; const size_t t0 = (size_t)b * SEQ + 64 * n; (void)t0;
        bf16x8 af[2][4];
#pragma unroll
        for (int db = 0; db < 2; ++db) {
            const int dl = 32 * db + pi32(r); const size_t ro = ((size_t)((b * 4 + h) * 64 + n) * 64 + dl) * 64 + 8 * hh;
            float gv[4][8]; v4u kraw[4];
#pragma unroll
            for (int s = 0; s < 4; ++s) { const v4u graw = *(const v4u*)(Gtt + ro + 16 * s); kraw[s] = *(const v4u*)(Ktb + ro + 16 * s);
#pragma unroll
                for (int i = 0; i < 4; ++i) { gv[s][2 * i] = pg8::bflo(graw[i]); gv[s][2 * i + 1] = pg8::bfhi(graw[i]); } }
            float tot[4], pt[4], offs[4], off = 0.f;
#pragma unroll
            for (int s = 0; s < 4; ++s) {
#pragma unroll
                for (int jj = 1; jj < 8; ++jj) gv[s][jj] += gv[s][jj - 1];
                tot[s] = gv[s][7]; }
#pragma unroll
            for (int s = 0; s < 4; ++s) pt[s] = __shfl_xor(tot[s], 32);
#pragma unroll
            for (int s = 0; s < 4; ++s) { offs[s] = off + (hh ? pt[s] : 0.f); off += tot[s] + pt[s]; }
            const float glast = off;
#pragma unroll
            for (int s = 0; s < 4; ++s) { float kk[8];
#pragma unroll
                for (int i = 0; i < 4; ++i) { kk[2 * i] = pg8::bflo(kraw[s][i]); kk[2 * i + 1] = pg8::bfhi(kraw[s][i]); }
#pragma unroll
                for (int jj = 0; jj < 8; ++jj) kk[jj] *= __expf(glast - (offs[s] + gv[s][jj]));
                af[db][s] = pack_frag(kk[0], kk[1], kk[2], kk[3], kk[4], kk[5], kk[6], kk[7]); }
            if (eh == 0 && hh == 0) DEC[(size_t)(it >> 1) * 64 + dl] = __expf(glast);
        }
        f32x16 acc[2][2];
#pragma unroll
        for (int db = 0; db < 2; ++db)
#pragma unroll
            for (int eb = 0; eb < 2; ++eb)
#pragma unroll
                for (int i = 0; i < 16; ++i) acc[db][eb][i] = 0.f;
#pragma unroll
        for (int eb = 0; eb < 2; ++eb)
#pragma unroll
            for (int s = 0; s < 4; ++s) { const bf16x8 vf = *(const bf16x8*)(Vtb + ((size_t)((b * 4 + h) * 64 + n) * 128 + 64 * eh + 32 * eb + r) * 64 + 16 * s + 8 * hh);
#pragma unroll
                for (int db = 0; db < 2; ++db) acc[db][eb] = MFMA32(af[db][s], vf, acc[db][eb]); }
#pragma unroll
        for (int db = 0; db < 2; ++db)
#pragma unroll
            for (int eb = 0; eb < 2; ++eb)
#pragma unroll
                for (int q = 0; q < 4; ++q) KV[((((size_t)it * 2 + db) * 2 + eb) * 4 + q) * 64 + lane] = (v2u){pk2(acc[db][eb][4 * q], acc[db][eb][4 * q + 1]), pk2(acc[db][eb][4 * q + 2], acc[db][eb][4 * q + 3])};
    }
}
__device__ __forceinline__ void gla_scan_phase(Frame& F, unsigned char* ws, const unsigned char* kvbuf) {
    const bf16* KV = (const bf16*)kvbuf; const float* DEC = (const float*)(ws + WS_DEC); unsigned char* ST = (unsigned char*)kvbuf - 4 * MiB;
    for (int t2 = F.r * (NWAVES * 64) + F.tid; t2 < 4 * 4096; t2 += F.nl * NWAVES * 64) {
        const int half = t2 & 1, t = t2 >> 1;
        const int lane = t & 63, q = (t >> 6) & 3, eb = (t >> 8) & 1, db = (t >> 9) & 1, eh = (t >> 10) & 1, h = t >> 11, b = F.x, hi = lane >> 5;
        const int d0 = 32 * db + 16 * (q >> 1) + 8 * hi + 4 * (q & 1) + 2 * half;
        f32x2_t S = (f32x2_t){0.f, 0.f};
#pragma unroll 32
        for (int n = 0; n < NCH; ++n) {
            const size_t cu = ((size_t)(b * NCH + n) * 4 + h); const size_t slot = ((((cu * 2 + eh) * 2 + db) * 2 + eb) * 4 + q) * 64 + lane;
            const unsigned kw = *(const unsigned*)(KV + slot * 4 + 2 * half); const f32x2_t kv = (f32x2_t){pg8::bflo(kw), pg8::bfhi(kw)}; const f32x2_t dc = *(const f32x2_t*)(DEC + cu * 64 + d0);
            *(unsigned*)(ST + (((((cu * 2 + eh) * 2 + db) * 2 + eb) * 2 + (q >> 1)) * 64 + lane) * 16 + (q & 1) * 8 + half * 4) = pk2(S[0], S[1]);
            S = dc * S + kv;
        }
    }
}
template <int IB> __device__ __forceinline__ void gla_main_item(unsigned char* ws, const float* par, bf16* Y, int cu, int h, size_t t0, int lane, LAS unsigned char* tl, const unsigned char* stbuf) {
    const bf16* Bq = (const bf16*)(ws + WS_BQ); const bf16* Bk = (const bf16*)(ws + WS_BK); const bf16* Gg = (const bf16*)(ws + WS_GG); const bf16* Br = (const bf16*)(ws + WS_BR);
    const bf16* Vtb = (const bf16*)(ws + WS_VTB); const unsigned char* ST = stbuf;
    const int r = lane & 31, hh = lane >> 5, tix = ((cu >> 8) * 4 + h) * 64 + ((cu >> 2) & 63);
    asm volatile("s_waitcnt lgkmcnt(0)" ::: "memory");
#pragma unroll
    for (int j = 0; j < 8; ++j) __builtin_amdgcn_global_load_lds((const unsigned*)(Br + (t0 + 32 * IB + 4 * j + (lane >> 4)) * 512 + h * 128 + (lane & 15) * 8), (LAS unsigned*)(tl + j * 1024), 16, 0, 0);
    v4u qraw[4], kraw[IB + 1][4], stv[16]; bf16x8 gt[2][2 * (IB + 1)];
    { const bf16* gtp = (const bf16*)(ws + WS_GTT) + ((size_t)tix * 64) * 64;
#pragma unroll
      for (int db = 0; db < 2; ++db)
#pragma unroll
          for (int ks = 0; ks < 2 * (IB + 1); ++ks) gt[db][ks] = *(const bf16x8*)(gtp + (size_t)(32 * db + pi32(r)) * 64 + 16 * ks + 8 * hh); }
#pragma unroll
    for (int jb = 0; jb <= IB; ++jb) {
        const bf16* kp = Bk + (t0 + 32 * jb + r) * 256 + h * 64 + 8 * hh;
#pragma unroll
        for (int d0 = 0; d0 < 4; ++d0) kraw[jb][d0] = *(const v4u*)(kp + 16 * d0); }
    { const bf16* qp = Bq + (t0 + 32 * IB + r) * 256 + h * 64 + 8 * hh;
#pragma unroll
      for (int d0 = 0; d0 < 4; ++d0) qraw[d0] = *(const v4u*)(qp + 16 * d0); }
#pragma unroll
    for (int eb = 0; eb < 4; ++eb)
#pragma unroll
        for (int d0 = 0; d0 < 4; ++d0) { const int db = d0 >> 1, sg = d0 & 1, eh = eb >> 1, e2 = eb & 1;
            stv[eb * 4 + d0] = *(const v4u*)(ST + ((((((size_t)cu * 2 + eh) * 2 + db) * 2 + e2) * 2 + sg) * 64 + lane) * 16); }
    __builtin_amdgcn_sched_barrier(0);
    float gg[IB + 1][4][8];
    { v4u t0w, t1w; const v4u onew = (v4u){0x3F803F80u, 0x3F803F80u, 0x3F803F80u, 0x3F803F80u};
#pragma unroll
      for (int i = 0; i < 4; ++i) { const int s = 8 * hh + 2 * i;
          t0w[i] = (s <= r ? 0x3F80u : 0u) | (s + 1 <= r ? 0x3F800000u : 0u); t1w[i] = (16 + s <= r ? 0x3F80u : 0u) | (17 + s <= r ? 0x3F800000u : 0u); }
      const bf16x8 tri0 = __builtin_bit_cast(bf16x8, t0w), tri1 = __builtin_bit_cast(bf16x8, t1w), ones = __builtin_bit_cast(bf16x8, onew);
#pragma unroll
      for (int jb = 0; jb <= IB; ++jb)
#pragma unroll
          for (int db = 0; db < 2; ++db) { f32x16 c;
#pragma unroll
              for (int i = 0; i < 16; ++i) c[i] = 0.f;
              if (jb == 1) { c = MFMA32(gt[db][0], ones, c); c = MFMA32(gt[db][1], ones, c); }
              c = MFMA32(gt[db][2 * jb], tri0, c); c = MFMA32(gt[db][2 * jb + 1], tri1, c);
#pragma unroll
              for (int i = 0; i < 16; ++i) gg[jb][2 * db + (i >> 3)][i & 7] = c[i]; } }
    bf16x8 qd[4];
#pragma unroll
    for (int d0 = 0; d0 < 4; ++d0) { float qq[8];
#pragma unroll
        for (int i = 0; i < 4; ++i) { qq[2 * i] = pg8::bflo(qraw[d0][i]); qq[2 * i + 1] = pg8::bfhi(qraw[d0][i]); }
#pragma unroll
        for (int jj = 0; jj < 8; ++jj) qq[jj] *= __expf(gg[IB][d0][jj]);
        qd[d0] = pack_frag(qq[0], qq[1], qq[2], qq[3], qq[4], qq[5], qq[6], qq[7]); }
    f32x16 o[4];
#pragma unroll
    for (int eb = 0; eb < 4; ++eb)
#pragma unroll
        for (int i = 0; i < 16; ++i) o[eb][i] = 0.f;
#pragma unroll
    for (int eb = 0; eb < 4; ++eb)
#pragma unroll
        for (int d0 = 0; d0 < 4; ++d0) o[eb] = MFMA32(qd[d0], __builtin_bit_cast(bf16x8, stv[eb * 4 + d0]), o[eb]);
#pragma unroll
    for (int jb = 0; jb <= IB; ++jb) {
        f32x16 st;
#pragma unroll
        for (int i = 0; i < 16; ++i) st[i] = 0.f;
#pragma unroll
        for (int d0 = 0; d0 < 4; ++d0) { float kk[8];
#pragma unroll
            for (int i = 0; i < 4; ++i) { kk[2 * i] = pg8::bflo(kraw[jb][d0][i]); kk[2 * i + 1] = pg8::bfhi(kraw[jb][d0][i]); }
#pragma unroll
            for (int jj = 0; jj < 8; ++jj) kk[jj] *= __expf(-gg[jb][d0][jj]);
            st = MFMA32(pack_frag(kk[0], kk[1], kk[2], kk[3], kk[4], kk[5], kk[6], kk[7]), qd[d0], st); }
        if (jb == IB) {
#pragma unroll
            for (int i = 0; i < 16; ++i) if (crow(i, hh) > r) st[i] = 0.f;
        }
#pragma unroll
        for (int sg = 0; sg < 2; ++sg) {
            const bf16x8 pf = pack_frag(st[8 * sg], st[8 * sg + 1], st[8 * sg + 2], st[8 * sg + 3], st[8 * sg + 4], st[8 * sg + 5], st[8 * sg + 6], st[8 * sg + 7]);
#pragma unroll
            for (int eb = 0; eb < 4; ++eb) {
                const bf16* vp = Vtb + ((size_t)tix * 128 + 32 * eb + r) * 64 + 32 * jb + 16 * sg + 4 * hh;
                const v2u lo = *(const v2u*)vp, hi2 = *(const v2u*)(vp + 8); const v4u vv = (v4u){lo.x, lo.y, hi2.x, hi2.y};
                o[eb] = MFMA32(pf, __builtin_bit_cast(bf16x8, vv), o[eb]); }
        }
    }
    float ss[16];
#pragma unroll
    for (int i = 0; i < 16; ++i) ss[i] = (o[0][i] * o[0][i] + o[1][i] * o[1][i]) + (o[2][i] * o[2][i] + o[3][i] * o[3][i]);
#pragma unroll
    for (int of = 1; of < 32; of <<= 1) { float t[16];
#pragma unroll
        for (int i = 0; i < 16; ++i) t[i] = __shfl_xor(ss[i], of);
#pragma unroll
        for (int i = 0; i < 16; ++i) ss[i] += t[i]; }
#pragma unroll
    for (int i = 0; i < 16; ++i) ss[i] = rsqrtf(ss[i] * (1.0f / 128.0f) + pg8::RMS_EPS);
    asm volatile("s_waitcnt vmcnt(0)" ::: "memory");
#pragma unroll
    for (int eb = 0; eb < 4; ++eb) { const float g = par[PAR_OUTG + 32 * eb + r];
#pragma unroll
        for (int i = 0; i < 16; ++i) { LAS bf16* const p = (LAS bf16*)(tl + crow(i, hh) * 256 + (32 * eb + r) * 2); const float sr = bf2f(*p); *p = f2bf(o[eb][i] * ss[i] * g * sr); } }
    LDS_WAIT(); asm volatile("" ::: "memory");
#pragma unroll
    for (int j = 0; j < 8; ++j) { const int row = 4 * j + (lane >> 4), ch = lane & 15; const v4u vv = *(const LAS v4u*)(tl + row * 256 + ch * 16);
        *(v4u*)(Y + (t0 + 32 * IB + row) * 1024 + 512 + h * 128 + ch * 8) = vv; }
}
__device__ __forceinline__ void gla_main_phase(Frame& F, unsigned char* ws, const float* par, bf16* Y, const unsigned char* stbuf) {
    const bool bypanel = F.nl == 32;
    for (int itl = F.r * NWAVES + F.wave; itl < NCH * 4 * 2; itl += F.nl * NWAVES) {
        const int b = F.x, it = bypanel ? ((((itl >> 8) * 32 + 4 * (F.r & 7) + (F.r >> 3)) << 3) | (itl & 7)) : b * 512 + itl, ib = it & 1, h = (it >> 1) & 3, n = (it >> 3) & 63; const size_t t0 = (size_t)b * SEQ + 64 * n;
        LAS unsigned char* const tl = F.lds + RING_OFF + F.wave * 16384;
        const int lane_ = pg8::opaque_i(F.lane);
        if (ib == 0) gla_main_item<0>(ws, par, Y, it >> 1, h, t0, lane_, tl, stbuf); else gla_main_item<1>(ws, par, Y, it >> 1, h, t0, lane_, tl, stbuf);
    }
}

__global__ void __launch_bounds__(NWAVES * 64, 2) mk_fwd(Args args) {
    extern __shared__ __attribute__((aligned(16))) unsigned char lds[];
    unsigned char* const ws = args.ws;
    volatile LAS unsigned* const MISC = (volatile LAS unsigned*)((LAS unsigned char*)lds + MISC_OFF);
    { const int tid = threadIdx.x; for (int u = tid; u < (LDS_BYTES - LDSCTL_OFF) / 4; u += NWAVES * 64) ((LAS unsigned*)((LAS unsigned char*)lds + LDSCTL_OFF))[u] = 0u; }
    __syncthreads();
    { const XcdBarrier bar = xcd_barrier_post((unsigned*)(ws + WS_CTL) + CW_BAR, MISC + 8); if (threadIdx.x == 0) MISC[20] = bar.x; }
    if (threadIdx.x == 0) {
        const unsigned x = xb_xcc_id();
        MISC[16] = x; MISC[17] = __hip_atomic_fetch_add((unsigned*)(ws + WS_CTL) + CW_RANK + 64 * (x & 15u), 1u, __ATOMIC_RELAXED, __HIP_MEMORY_SCOPE_AGENT); MISC[18] = 1u;
    }
    __syncthreads();
#define GRID_BAR() do { volatile LAS unsigned* const M_ = (volatile LAS unsigned*)((LAS unsigned char*)lds + pg8::opaque_i(MISC_OFF)); XcdBarrier b_; b_.bar = (unsigned*)(ws + WS_CTL) + CW_BAR; b_.x = M_[20]; b_.st = M_ + 8; xcd_barrier(b_, M_[19] == 0u); } while (0)
    { Frame F = make_frame(lds); p0_weights(F, args); }
    GRID_BAR();
    if (threadIdx.x == 0) {
        const unsigned* xc = (const unsigned*)(ws + WS_CTL) + CW_BAR; unsigned cnt[16], tot = 0; bool ok = true;
#pragma unroll
        for (int j = 0; j < 16; ++j) { cnt[j] = __hip_atomic_load(xc + XB_XCNT(j), __ATOMIC_RELAXED, __HIP_MEMORY_SCOPE_AGENT); tot += cnt[j]; ok = ok && (j < 8 ? cnt[j] > 0u : cnt[j] == 0u); }
        ok = ok && tot == gridDim.x;
        const unsigned x = MISC[16];
        MISC[19] = ok ? 1u : 0u;
        if (ok) { unsigned nl = 0;
#pragma unroll
            for (int j = 0; j < 8; ++j) nl = (j == (int)x) ? cnt[j] : nl;
            MISC[18] = nl; }
        else { const unsigned G = gridDim.x, bx = blockIdx.x; MISC[16] = bx & 7u; MISC[17] = bx >> 3; MISC[18] = (G - (bx & 7u) + 7u) >> 3; }
    }
    __syncthreads();
#define ARENA_PTR(F) (ws + WS_ARENA0 + (size_t)(F).xr * ARENA)
#define PANEL_SEAM(s) do { volatile LAS unsigned* const M_ = (volatile LAS unsigned*)((LAS unsigned char*)lds + pg8::opaque_i(MISC_OFF)); \
    if (__builtin_amdgcn_readfirstlane((int)M_[19]) != 0 && __builtin_amdgcn_readfirstlane((int)M_[18]) == 32) \
        head_group_sync((unsigned*)(ws + WS_CTL) + CW_GRP + 8192 + (s) * 8192 + ((l * 8 + (int)(M_[16] & 7u)) * 8 + (int)(M_[17] & 7u)) * 32, (unsigned*)(ws + WS_CTL) + CW_BAR + XB_TMO, 4u); \
    else GRID_BAR(); } while (0)
#define X8_PTR(F) ((unsigned char*)args.out + (size_t)(F).xr * (16 * MiB) + 8 * MiB)
    { Frame F = make_frame(lds); p0_x(F, args, ARENA_PTR(F), X8_PTR(F)); }
    GRID_BAR();
    for (int l = 0; l < DEPTH; ++l) {
        unsigned char* const wl = ws + WS_W0 + (size_t)l * W_LAYER; const float* const par = (const float*)(ws + WS_PAR + (size_t)l * PAR_LAYER_BYTES);
        {   Frame F = make_frame(lds); unsigned char* const wsb = ARENA_PTR(F); fill_rstd_lds(F, (const float*)(wsb + WS_PARTA));
            pg8::Gemm g{(const pg8::bf16_t*)(wsb + WS_XB), (const pg8::bf16_t*)(wl + WO_IN_N), SEQ, 9 * 256, DM}; XcdOrder<8, false, 6> S{F.x, F.r, F.nl};
            pg8::EpiInN E{(const LAS float*)((LAS unsigned char*)lds + RSTD_LDS_OFF), wsb, par, 0};
            pg8::gemm_phase<pg8::EpiInN, XcdOrder<8, false, 6>, true, true>((LAS unsigned char*)lds + RING_OFF, g, S, E); }
        {   Frame F = make_frame(lds); unsigned char* const wsb = ARENA_PTR(F);
            pg8::Gemm g{(const pg8::bf16_t*)X8_PTR(F), (const pg8::bf16_t*)(wl + WO_IN_G8), SEQ, 9 * 256, DM / 2}; XcdOrder<9, false> S{F.x, F.r, F.nl};
            pg8::EpiGate E{(const LAS float*)((LAS unsigned char*)lds + RSTD_LDS_OFF), wsb, par};
            pg8::gemm_phase<pg8::EpiGate, XcdOrder<9, false>, true, true, false, true>((LAS unsigned char*)lds + RING_OFF, g, S, E); }
        {   Frame F = make_frame(lds); unsigned char* const wsb = ARENA_PTR(F); pg8::Gemm g{(const pg8::bf16_t*)(wl + WO_IN_T), (const pg8::bf16_t*)(wsb + WS_XB), NIN_T, SEQ, DM}; XcdOrder<NIN_T / 256, true> S{F.x, F.r, F.nl};
            pg8::EpiInT E{(const LAS float*)((LAS unsigned char*)lds + RSTD_LDS_OFF), wsb, par};
            pg8::gemm_phase<pg8::EpiInT, XcdOrder<NIN_T / 256, true>, true, true>((LAS unsigned char*)lds + RING_OFF, g, S, E); }
        GRID_BAR();
#define Y_PTR(F) ((bf16*)((unsigned char*)args.out + (size_t)(F).xr * (16 * MiB)))
        {   Frame F = make_frame(lds); attn_phase(F, ARENA_PTR(F), par, Y_PTR(F)); gla_kv_phase(F, ARENA_PTR(F), X8_PTR(F) + 4 * MiB);
            const bool grp = (((volatile LAS unsigned*)((LAS unsigned char*)lds + pg8::opaque_i(MISC_OFF)))[19] != 0u) && F.nl == 32;
            if (grp) head_group_sync((unsigned*)(ws + WS_CTL) + CW_GRP + ((l * 8 + F.xr) * 4 + (F.r >> 3)) * 32, (unsigned*)(ws + WS_CTL) + CW_BAR + XB_TMO); else GRID_BAR();
            gla_scan_phase(F, ARENA_PTR(F), X8_PTR(F) + 4 * MiB); }
        GRID_BAR();
        { Frame F = make_frame(lds); gla_main_phase(F, ARENA_PTR(F), par, Y_PTR(F), X8_PTR(F)); }
        PANEL_SEAM(2);
        {   Frame F = make_frame(lds); unsigned char* const wsb = ARENA_PTR(F); pg8::Gemm g{(const pg8::bf16_t*)Y_PTR(F), (const pg8::bf16_t*)(wl + WO_BR), SEQ, DM, DM}; XcdOrder<4, false> S{F.x, F.r, F.nl};
            pg8::EpiBranch E{wsb};
            pg8::gemm_phase<pg8::EpiBranch, XcdOrder<4, false>, false, true>((LAS unsigned char*)lds + RING_OFF, g, S, E); }
        PANEL_SEAM(0);
        {   Frame F = make_frame(lds); unsigned char* const wsb = ARENA_PTR(F); pg8::Gemm g{(const pg8::bf16_t*)(wsb + WS_MIX), (const pg8::bf16_t*)(wl + WO_OUT), SEQ, DM, DM}; XcdOrder<4, false> S{F.x, F.r, F.nl};
            pg8::EpiRes E{(pg8::bf16_t*)(wsb + WS_XB), (float*)(wsb + WS_PARTF), nullptr, nullptr};
            pg8::gemm_phase<pg8::EpiRes, XcdOrder<4, false>, false, true>((LAS unsigned char*)lds + RING_OFF, g, S, E); }
        GRID_BAR();
        {   Frame F = make_frame(lds); unsigned char* const wsb = ARENA_PTR(F); fill_rstd_lds(F, (const float*)(wsb + WS_PARTF));
            pg8::Gemm g{(const pg8::bf16_t*)(wsb + WS_XB), (const pg8::bf16_t*)(wl + WO_UP), SEQ, DFF, DM}; XcdOrder<16, false> S{F.x, F.r, F.nl};
            pg8::EpiUp E{(const LAS float*)((LAS unsigned char*)lds + RSTD_LDS_OFF), wsb};
            pg8::gemm_phase<pg8::EpiUp, XcdOrder<16, false>, true, true>((LAS unsigned char*)lds + RING_OFF, g, S, E); }
        PANEL_SEAM(1);
        {   Frame F = make_frame(lds); unsigned char* const wsb = ARENA_PTR(F); pg8::Gemm g{(const pg8::bf16_t*)(wsb + WS_HID), (const pg8::bf16_t*)(wl + WO_DN), SEQ, DM, DFF}; XcdOrder<4, false> S{F.x, F.r, F.nl};
            pg8::EpiRes E{(pg8::bf16_t*)(wsb + WS_XB), (float*)(wsb + WS_PARTA), l == DEPTH - 1 ? args.out + (size_t)F.xr * SEQ * DM : nullptr, l == DEPTH - 1 ? nullptr : X8_PTR(F)};
            pg8::gemm_phase<pg8::EpiRes, XcdOrder<4, false>, false, true, true>((LAS unsigned char*)lds + RING_OFF, g, S, E); }
        GRID_BAR();
    }
    if (__hip_atomic_load((unsigned*)(ws + WS_CTL) + CW_BAR + XB_TMO, __ATOMIC_RELAXED, __HIP_MEMORY_SCOPE_AGENT) != 0u) {
        const float qn = __builtin_nanf(""); const int tid = threadIdx.x;
        for (size_t i = (size_t)blockIdx.x * 512 + tid; i < (size_t)MT * DM / 4; i += (size_t)gridDim.x * 512) ((f32x4*)args.out)[i] = (f32x4){qn, qn, qn, qn};
    }
}

extern "C" void kernel_launch(void* const* d_in, const int* in_sizes, int n_in, void* d_out, int out_size, void* d_ws, size_t ws_size, hipStream_t stream) {
    static int grid = 0;
    if (grid == 0) {
        if (n_in != 18 || out_size != MT * DM || ws_size < WS_END) { fprintf(stderr, "kernel_launch: unexpected problem (n_in %d, out %d, ws %zu)\n", n_in, out_size, ws_size); grid = -1; return; }
        int dev = 0, cus = 0, per_cu = 0;
        if (hipGetDevice(&dev) != hipSuccess || hipDeviceGetAttribute(&cus, hipDeviceAttributeMultiprocessorCount, dev) != hipSuccess) { grid = -1; return; }
        if (hipFuncSetAttribute((const void*)mk_fwd, hipFuncAttributeMaxDynamicSharedMemorySize, LDS_BYTES) != hipSuccess) { grid = -1; return; }
        if (hipOccupancyMaxActiveBlocksPerMultiprocessor(&per_cu, (const void*)mk_fwd, NWAVES * 64, LDS_BYTES) != hipSuccess || per_cu < 1) { fprintf(stderr, "kernel_launch: occupancy query reports %d\n", per_cu); }
        (void)hipGetLastError();
        grid = cus;
    }
    if (grid < 0) return;
    if (hipMemsetAsync((char*)d_ws + WS_CTL, 0, CTL_ZERO_BYTES, stream) != hipSuccess) return;
    Args a{};
    a.x = (const float*)d_in[0]; a.norm_mix = (const float*)d_in[1]; a.w_in = (const float*)d_in[2]; a.a_q_norm = (const float*)d_in[3]; a.a_k_norm = (const float*)d_in[4];
    a.lq1 = (const float*)d_in[5]; a.lk1 = (const float*)d_in[6]; a.lq2 = (const float*)d_in[7]; a.lk2 = (const float*)d_in[8]; a.a_sub_norm = (const float*)d_in[9];
    a.b_gate_up = (const float*)d_in[10]; a.b_gate_bias = (const float*)d_in[11]; a.b_out_norm = (const float*)d_in[12]; a.w_branch = (const float*)d_in[13]; a.w_out = (const float*)d_in[14];
    a.norm_ffn = (const float*)d_in[15]; a.w_up = (const float*)d_in[16]; a.w_down = (const float*)d_in[17];
    a.out = (float*)d_out; a.ws = (unsigned char*)d_ws;
    for (int l = 0; l < 4; ++l) a.lam_init[l] = (float)(0.8 - 0.6 * exp(-0.3 * l));
    a.ph_lo = 0; a.ph_hi = 0;
    hipLaunchKernelGGL(mk_fwd, dim3(grid), dim3(NWAVES * 64), LDS_BYTES, stream, a);
}
```

```cpp
#include <hip/hip_runtime.h>
#include <cstdio>
#include <cstdint>
#include <cmath>
constexpr int NWAVES = 8;
constexpr int DM = 1024, SEQ = 4096, NB = 8, MT = NB * SEQ  , DEPTH = 4, DFF = 4096, DIN = 5136;
constexpr int NCH = 64;
constexpr int NIN_N = 4352, NIN_T = 1024;
constexpr int C_AQ = 0, C_AK = 512, C_AV = 1024, C_BQ = 1536, C_BK = 1792, C_BV = 2048, C_BA = 2560, C_BR = 2576, C_GT = 3088;
constexpr size_t MiB = 1u << 20;
constexpr size_t WS_CTL = 0, CTL_ZERO_BYTES = 512 * 1024;
constexpr size_t WS_PAR = 512 * 1024, PAR_LAYER_BYTES = 4096;
constexpr int PAR_QG = 0, PAR_KG = 64, PAR_ZB = 128, PAR_SUB = 384, PAR_OUTG = 512, PAR_LAM = 640, PAR_NEGB = 641, PAR_ONEM = 642;
constexpr int CW_BAR = 4096, CW_RANK = 8192, CW_GRP = 16384;
constexpr size_t WS_W0 = 2 * MiB, W_LAYER = (size_t)63 * MiB / 2;
constexpr size_t WO_ZBA = (size_t)6 * 256 * DM * 2, WO_ZUP = WO_ZBA + 32768;
constexpr size_t WO_IN_G8 = (size_t)9 * 256 * DM * 2;
constexpr size_t WO_IN_N = 0, WO_IN_T = WO_IN_N + (size_t)NIN_N * DM * 2, WO_BR = WO_IN_T + (size_t)NIN_T * DM * 2, WO_OUT = WO_BR + 2 * MiB, WO_UP = WO_OUT + 2 * MiB, WO_DN = WO_UP + 8 * MiB;
static_assert(WO_DN + 8 * MiB <= W_LAYER && WS_W0 + 4 * W_LAYER <= 128 * MiB, "weights");
constexpr size_t WS_ARENA0 = 128 * MiB, ARENA = 47 * MiB;
constexpr size_t WS_XB = 0;
constexpr size_t WS_QA = 8 * MiB, WS_KA = 12 * MiB, WS_VTA = 16 * MiB, WS_BQ = 20 * MiB, WS_BK = 22 * MiB, WS_GG = 24 * MiB  , WS_BR = 26 * MiB, WS_GT = 30 * MiB  ,
                 WS_VTB = 38 * MiB, WS_KTB = 42 * MiB, WS_GTT = 44 * MiB  ;
constexpr size_t WS_PARTF = 46 * MiB, WS_PARTA = 46 * MiB + 256 * 1024, WS_DEC = 46 * MiB + 512 * 1024;
constexpr size_t WS_END = WS_ARENA0 + 8 * ARENA;
constexpr size_t WS_MIX = WS_QA;
constexpr size_t WS_KV = WS_QA;
constexpr size_t WS_ST = WS_VTA;
constexpr size_t WS_HID = WS_QA;
static_assert(WS_HID + (size_t)SEQ * DFF * 2 <= WS_PARTF && WS_DEC + 65536 <= ARENA && WS_END <= 504 * MiB, "arena");
namespace pg8 {
#define PG8_LAS __attribute__((address_space(3)))
typedef unsigned short bf16_t;
typedef short bf16x8 __attribute__((ext_vector_type(8)));
typedef float f32x4 __attribute__((ext_vector_type(4)));
typedef unsigned u32x4 __attribute__((ext_vector_type(4)));
constexpr int BM = 256, BK = 64, HALF = 128, HTB = HALF * BK * 2  , STAGE_BYTES = 8 * HTB, NXCD = 8, WGM = 8;

__host__ __device__ __forceinline__ int lds_byte(int r, int c) { const int st = (r >> 4) * 2 + (c >> 5), rr = r & 15, cc = c & 31, ob = rr * 64 + cc * 2; return st * 1024 + (ob ^ (((ob >> 9) & 1) << 5)); }
__host__ __device__ __forceinline__ void stage_rc(int b, int& R, int& C) { const int st = b / 1024, sb = b % 1024, swz = sb ^ (((sb >> 9) & 1) << 5); R = (st >> 1) * 16 + swz / 64; C = (st & 1) * 32 + (swz % 64) / 2; }
__host__ __device__ __forceinline__ int perm32(int rho) { const int n = rho >> 4, i = rho & 15; return 8 * (i >> 2) + 4 * n + (i & 3); }

struct Unit { int pm, pn; };
struct Gemm { const bf16_t* A; const bf16_t* Bt; int M, N, K; };

struct StaticOrder {
    int nM, nN, nwg, G, c;
    __host__ __device__ void init(int M, int N, int G_, int c_) { nM = M / BM; nN = N / BM; nwg = nM * nN; G = G_; c = c_; }
    __host__ __device__ bool next(int i, Unit& u) const {
        const long L = (long)i * G + c; if (L >= nwg) return false;
        int wgid = (int)L; { const int q = nwg / NXCD, r = nwg % NXCD, xcd = wgid % NXCD, off = wgid / NXCD; wgid = (xcd < r ? xcd * (q + 1) : r * (q + 1) + (xcd - r) * q) + off; }
        const int nig = WGM * nN, gid = wgid / nig, fm = gid * WGM, gsz = (nM - fm) < WGM ? (nM - fm) : WGM;
        u.pm = fm + ((wgid % nig) % gsz); u.pn = (wgid % nig) / gsz; return true;
    }
    __device__ __forceinline__ void a_ready(const Unit&) const {}
    __device__ __forceinline__ void done(const Unit&) const {}
};

__device__ __forceinline__ unsigned cvt_pk_bf16(float lo, float hi) { unsigned r; asm volatile("v_cvt_pk_bf16_f32 %0, %1, %2" : "=v"(r) : "v"(lo), "v"(hi)); return r; }
typedef unsigned u32x2 __attribute__((ext_vector_type(2)));
typedef int i32x4 __attribute__((ext_vector_type(4))); typedef int i32x8 __attribute__((ext_vector_type(8)));
__device__ __forceinline__ i32x8 cat8(bf16x8 a, bf16x8 b) { return __builtin_shufflevector(__builtin_bit_cast(i32x4, a), __builtin_bit_cast(i32x4, b), 0, 1, 2, 3, 4, 5, 6, 7); }
__device__ __forceinline__ unsigned pk4_fp8(f32x4 v) { unsigned w = 0u; w = (unsigned)__builtin_amdgcn_cvt_pk_fp8_f32(v[0], v[1], (int)w, false); w = (unsigned)__builtin_amdgcn_cvt_pk_fp8_f32(v[2], v[3], (int)w, true); return w; }
constexpr float RMS_EPS = 1e-6f;
constexpr int MTOK = 32768;
__device__ __forceinline__ int opaque_i(int v) { asm volatile("" : "+v"(v)); return v; }
__device__ __forceinline__ float sum16(const float* p) { const f32x4 a = *(const f32x4*)p, b = *(const f32x4*)(p + 4), c = *(const f32x4*)(p + 8), d = *(const f32x4*)(p + 12);
    return (((a[0] + a[1]) + (a[2] + a[3])) + ((b[0] + b[1]) + (b[2] + b[3]))) + (((c[0] + c[1]) + (c[2] + c[3])) + ((d[0] + d[1]) + (d[2] + d[3]))); }
__device__ __forceinline__ float sigmoidf_(float v) { return __builtin_amdgcn_rcpf(1.f + __expf(-v)); }
__device__ __forceinline__ float bflo(unsigned w) { return __uint_as_float(w << 16); }
__device__ __forceinline__ float bfhi(unsigned w) { return __uint_as_float(w & 0xffff0000u); }
__device__ __forceinline__ u32x4 pack8(const f32x4 a, const f32x4 b) { u32x4 w; w.x = cvt_pk_bf16(a[0], a[1]); w.y = cvt_pk_bf16(a[2], a[3]); w.z = cvt_pk_bf16(b[0], b[1]); w.w = cvt_pk_bf16(b[2], b[3]); return w; }

struct EpiInN {
    static constexpr bool PERM = true, HAS_MID = false;
    const PG8_LAS float* ssq; unsigned char* ws; const float* par; int pn0;
    __device__ __forceinline__ void mid(f32x4 (&)[2][2][4][2], const Unit&, int, int, int, int) const {}
    __device__ __forceinline__ void operator()(const f32x4 (&acc)[2][2][4][2], const Unit& u, int wr, int wc, int fr, int fq) const {
        const int pn = u.pn + pn0, row0 = u.pm * BM + wr * 64 + fr, cw = 64 * wc + 8 * fq;
        const float qscale = 0.125f * 1.4426950408889634f;
        float rs[2][4];
#pragma unroll
        for (int ai = 0; ai < 2; ++ai)
#pragma unroll
            for (int m = 0; m < 4; ++m) rs[ai][m] = ssq[(row0 + ai * HALF + m * 16) & 4095];
        if (pn < 4) {
            const float* gn = par + (pn < 2 ? PAR_QG : PAR_KG); const float sc = pn < 2 ? qscale : 1.f;
            bf16_t* O = (bf16_t*)(ws + (pn < 2 ? WS_QA : WS_KA)); const int colb = (pn & 1) * 256 + cw;
            f32x4 gv[2][2];
#pragma unroll
            for (int bj = 0; bj < 2; ++bj)
#pragma unroll
                for (int n = 0; n < 2; ++n) gv[bj][n] = *(const f32x4*)(gn + 32 * bj + 8 * fq + 4 * n) * sc;
#pragma unroll
            for (int ai = 0; ai < 2; ++ai)
#pragma unroll
                for (int m = 0; m < 4; ++m) {
                    const float r = rs[ai][m]; f32x4 v[2][2]; float ss = 0.f;
#pragma unroll
                    for (int bj = 0; bj < 2; ++bj)
#pragma unroll
                        for (int n = 0; n < 2; ++n) { v[bj][n] = acc[ai][bj][m][n] * r; const f32x4 x = v[bj][n]; ss += (x[0] * x[0] + x[1] * x[1]) + (x[2] * x[2] + x[3] * x[3]); }
                    ss += __shfl_xor(ss, 16); ss += __shfl_xor(ss, 32);
                    const float qr = rsqrtf(ss * (1.0f / 64.0f) + RMS_EPS);
                    bf16_t* rowp = O + (size_t)(row0 + ai * HALF + m * 16) * 512 + colb;
#pragma unroll
                    for (int bj = 0; bj < 2; ++bj) *(u32x4*)(rowp + 32 * bj) = pack8(v[bj][0] * qr * gv[bj][0], v[bj][1] * qr * gv[bj][1]);
                }
        } else if (pn == 6) {
            f32x4 bz[2][2];
#pragma unroll
            for (int bj = 0; bj < 2; ++bj)
#pragma unroll
                for (int n = 0; n < 2; ++n) bz[bj][n] = *(const f32x4*)(par + PAR_ZB + cw + 32 * bj + 4 * n);
#pragma unroll
            for (int ai = 0; ai < 2; ++ai)
#pragma unroll
                for (int m = 0; m < 4; ++m) {
                    const float r = rs[ai][m]; bf16_t* rowp = (bf16_t*)(ws + WS_GG) + (size_t)(row0 + ai * HALF + m * 16) * 256 + cw;
#pragma unroll
                    for (int bj = 0; bj < 2; ++bj) { f32x4 g[2];
#pragma unroll
                        for (int n = 0; n < 2; ++n) { const f32x4 z = acc[ai][bj][m][n] * r + bz[bj][n];
#pragma unroll
                            for (int e = 0; e < 4; ++e) g[n][e] = (fminf(z[e], 0.f) - __logf(1.f + __expf(-fabsf(z[e])))) * (1.0f / 16.0f); }
                        const u32x4 gw = pack8(g[0], g[1]); *(u32x4*)(rowp + 32 * bj) = gw;
                        const int t = row0 + ai * HALF + m * 16; bf16_t* tp = (bf16_t*)(ws + WS_GTT) + ((((size_t)((t >> 12) * 4 + wc) * 64 + ((t >> 6) & 63)) * 64 + 32 * bj + 8 * fq) << 6) + (t & 63);
#pragma unroll
                        for (int i = 0; i < 4; ++i) { tp[(2 * i) * 64] = (bf16_t)(gw[i] & 0xffffu); tp[(2 * i + 1) * 64] = (bf16_t)(gw[i] >> 16); } }
                }
        } else if (pn >= 9) {
            const int colb = (pn - 9) * 256 + cw; const float k255 = 1.0f / 255.0f;
#pragma unroll
            for (int ai = 0; ai < 2; ++ai)
#pragma unroll
                for (int m = 0; m < 4; ++m) {
                    const float c = rs[ai][m] * (-1.4426950408889634f / 32.0f);     unsigned char* rowp = ws + WS_GT + (size_t)(row0 + ai * HALF + m * 16) * 2048 + colb;
#pragma unroll
                    for (int bj = 0; bj < 2; ++bj) { const f32x4 t0 = acc[ai][bj][m][0] * c, t1 = acc[ai][bj][m][1] * c; u32x2 q; q.x = 0u; q.y = 0u;
#pragma unroll
                        for (int e = 0; e < 4; ++e) {
                            q.x = __builtin_amdgcn_cvt_pk_u8_f32(__builtin_amdgcn_rcpf(__builtin_fmaf(__builtin_amdgcn_exp2f(t0[e]), k255, k255)), e, q.x);
                            q.y = __builtin_amdgcn_cvt_pk_u8_f32(__builtin_amdgcn_rcpf(__builtin_fmaf(__builtin_amdgcn_exp2f(t1[e]), k255, k255)), e, q.y); }
                        *(u32x2*)(rowp + 32 * bj) = q; }
                }
        } else {
            bf16_t* O; int ld, colb; int mode;
            float sc = 1.f;
            if (pn == 4) { O = (bf16_t*)(ws + WS_BQ); ld = 256; colb = cw; mode = 0; sc = 0.125f; }
            else if (pn == 5) { O = (bf16_t*)(ws + WS_BK); ld = 256; colb = cw; mode = 0; }
            else { O = (bf16_t*)(ws + WS_BR); ld = 512; colb = (pn - 7) * 256 + cw; mode = 1; }
#pragma unroll
            for (int ai = 0; ai < 2; ++ai)
#pragma unroll
                for (int m = 0; m < 4; ++m) {
                    const float r = rs[ai][m] * sc; bf16_t* rowp = O + (size_t)(row0 + ai * HALF + m * 16) * ld + colb;
#pragma unroll
                    for (int bj = 0; bj < 2; ++bj) { f32x4 v0 = acc[ai][bj][m][0] * r, v1 = acc[ai][bj][m][1] * r;
                        if (mode != 0) {
#pragma unroll
                            for (int e = 0; e < 4; ++e) { v0[e] *= sigmoidf_(v0[e]); v1[e] *= sigmoidf_(v1[e]); } }
                        const u32x4 gw = pack8(v0, v1); *(u32x4*)(rowp + 32 * bj) = gw;
                        if (pn == 5) {
                            const int t = opaque_i(row0) + ai * HALF + m * 16, dq = opaque_i(8 * fq); bf16_t* tp = (bf16_t*)(ws + WS_KTB) + ((((size_t)((t >> 12) * 4 + wc) * 64 + ((t >> 6) & 63)) * 64 + 32 * bj + dq) << 6) + (t & 63);
#pragma unroll
                            for (int i = 0; i < 4; ++i) { tp[(2 * i) * 64] = (bf16_t)(gw[i] & 0xffffu); tp[(2 * i + 1) * 64] = (bf16_t)(gw[i] >> 16); } } }
                }
        }
    }
};
struct EpiGate {
    static constexpr bool PERM = true, HAS_MID = false;
    const PG8_LAS float* ssq; unsigned char* ws;
    __device__ __forceinline__ void mid(f32x4 (&)[2][2][4][2], const Unit&, int, int, int, int) const {}
    __device__ __forceinline__ void operator()(const f32x4 (&acc)[2][2][4][2], const Unit& u, int wr, int wc, int fr, int fq) const {
        const int tid_ = opaque_i(threadIdx.x), wid_ = tid_ >> 6, ln_ = tid_ & 63;
        const int row0 = u.pm * BM + (wid_ >> 2) * 64 + (ln_ & 15), colb = u.pn * 256 + 64 * (wid_ & 3) + 8 * (ln_ >> 4); const float k255 = 1.0f / 255.0f; (void)wr; (void)wc; (void)fr; (void)fq;
#pragma unroll
        for (int ai = 0; ai < 2; ++ai)
#pragma unroll
            for (int m = 0; m < 4; ++m) {
                const float c = ssq[(row0 + ai * HALF + m * 16) & 4095] * (-1.4426950408889634f / 32.0f); unsigned char* rowp = ws + WS_GT + (size_t)(row0 + ai * HALF + m * 16) * 2048 + colb;
#pragma unroll
                for (int bj = 0; bj < 2; ++bj) { const f32x4 t0 = acc[ai][bj][m][0] * c, t1 = acc[ai][bj][m][1] * c; u32x2 q; q.x = 0u; q.y = 0u;
#pragma unroll
                    for (int e = 0; e < 4; ++e) {
                        q.x = __builtin_amdgcn_cvt_pk_u8_f32(__builtin_amdgcn_rcpf(__builtin_fmaf(__builtin_amdgcn_exp2f(t0[e]), k255, k255)), e, q.x);
                        q.y = __builtin_amdgcn_cvt_pk_u8_f32(__builtin_amdgcn_rcpf(__builtin_fmaf(__builtin_amdgcn_exp2f(t1[e]), k255, k255)), e, q.y); }
                    *(u32x2*)(rowp + 32 * bj) = q; }
            }
    }
};
struct EpiInT {
    static constexpr bool PERM = true, HAS_MID = false;
    const PG8_LAS float* ssq; unsigned char* ws; const float* par;
    __device__ __forceinline__ void mid(f32x4 (&)[2][2][4][2], const Unit&, int, int, int, int) const {}
    __device__ __forceinline__ void operator()(const f32x4 (&acc)[2][2][4][2], const Unit& u, int wr, int wc, int fr, int fq) const {
        const int pm = u.pm, tok0 = u.pn * BM + wc * 32 + 8 * fq, frow0 = (pm < 4 ? (pm & 1) * 256 : 0) + wr * 64 + fr;
        f32x4 rt[2][2];
#pragma unroll
        for (int bj = 0; bj < 2; ++bj)
#pragma unroll
            for (int n = 0; n < 2; ++n) rt[bj][n] = *(const PG8_LAS f32x4*)(ssq + ((tok0 + bj * HALF + 4 * n) & 4095));
        size_t tb_[2];
#pragma unroll
        for (int bj = 0; bj < 2; ++bj) { const int t = tok0 + bj * HALF; tb_[bj] = (size_t)((t >> 12) * 4) * 64 + ((t >> 6) & 63); }
        if (pm < 5) {
            bf16_t* O = (bf16_t*)(ws + (pm < 2 ? WS_VTA : pm < 4 ? WS_VTB : WS_KTB)); const int fl2 = pm < 4 ? 7 : 6;
#pragma unroll
            for (int ai = 0; ai < 2; ++ai)
#pragma unroll
                for (int m = 0; m < 4; ++m) { const int fr_ = frow0 + ai * HALF + m * 16, hd = fr_ >> fl2, fe = fr_ & ((1 << fl2) - 1);
#pragma unroll
                    for (int bj = 0; bj < 2; ++bj) *(u32x4*)(O + ((((tb_[bj] + (size_t)hd * 64) << fl2) + fe) << 6) + ((tok0 + bj * HALF) & 63)) = pack8(acc[ai][bj][m][0] * rt[bj][0], acc[ai][bj][m][1] * rt[bj][1]); }
        } else {
#pragma unroll
            for (int ai = 0; ai < 2; ++ai)
#pragma unroll
                for (int m = 0; m < 4; ++m) { const int fr_ = frow0 + ai * HALF + m * 16, hd = fr_ >> 6, fe = fr_ & 63; const float bz = par[PAR_ZB + fr_];
#pragma unroll
                    for (int bj = 0; bj < 2; ++bj) { bf16_t* rowp = (bf16_t*)(ws + WS_GTT) + ((((tb_[bj] + (size_t)hd * 64) << 6) + fe) << 6) + ((tok0 + bj * HALF) & 63); f32x4 g[2];
#pragma unroll
                        for (int n = 0; n < 2; ++n) { const f32x4 z = acc[ai][bj][m][n] * rt[bj][n] + bz;
#pragma unroll
                            for (int e = 0; e < 4; ++e) g[n][e] = (fminf(z[e], 0.f) - __logf(1.f + __expf(-fabsf(z[e])))) * (1.0f / 16.0f); }
                        *(u32x4*)rowp = pack8(g[0], g[1]); } }
        }
    }
};
struct EpiUp {
    static constexpr bool PERM = true, HAS_MID = false;
    const PG8_LAS float* ssq; unsigned char* ws;
    __device__ __forceinline__ void mid(f32x4 (&)[2][2][4][2], const Unit&, int, int, int, int) const {}
    __device__ __forceinline__ void operator()(const f32x4 (&acc)[2][2][4][2], const Unit& u, int wr, int wc, int fr, int fq) const {
        const int row0 = u.pm * BM + wr * 64 + fr, col0 = u.pn * BM + wc * 32 + 8 * fq;
        float rr[2][4];
#pragma unroll
        for (int ai = 0; ai < 2; ++ai)
#pragma unroll
            for (int m = 0; m < 4; ++m) rr[ai][m] = ssq[(row0 + ai * HALF + m * 16) & 4095];
#pragma unroll
        for (int ai = 0; ai < 2; ++ai)
#pragma unroll
            for (int m = 0; m < 4; ++m) { const int row = row0 + ai * HALF + m * 16; const float r = rr[ai][m];
                bf16_t* rowp = (bf16_t*)(ws + WS_HID) + (((size_t)(row >> 8) * 64 + (col0 >> 6)) * 256 + (row & 255)) * 64 + (col0 & 63);
#pragma unroll
                for (int bj = 0; bj < 2; ++bj) { f32x4 v0 = acc[ai][bj][m][0] * r, v1 = acc[ai][bj][m][1] * r;
#pragma unroll
                    for (int e = 0; e < 4; ++e) { const float a = fmaxf(v0[e], 0.f), b = fmaxf(v1[e], 0.f); v0[e] = a * a; v1[e] = b * b; }
                    *(u32x4*)(rowp + bj * (2 * 256 * 64)) = pack8(v0, v1); } }
    }
};
struct EpiRes {
    static constexpr bool PERM = true, HAS_MID = false;
    bf16_t* xb; float* ssq; float* fout; unsigned char* x8;
    __device__ __forceinline__ void mid(f32x4 (&)[2][2][4][2], const Unit&, int, int, int, int) const {}
    __device__ __forceinline__ void operator()(const f32x4 (&acc)[2][2][4][2], const Unit& u, int wr, int wc, int fr, int fq) const {
        const int row0 = u.pm * BM + wr * 64 + fr, col0 = u.pn * BM + wc * 32 + 8 * fq;
        u32x4 pre[2][4][2];
#pragma unroll
        for (int ai = 0; ai < 2; ++ai)
#pragma unroll
            for (int m = 0; m < 4; ++m)
#pragma unroll
                for (int bj = 0; bj < 2; ++bj) pre[ai][m][bj] = *(const u32x4*)(xb + (size_t)(row0 + ai * HALF + m * 16) * 1024 + col0 + bj * HALF);
#pragma unroll
        for (int ai = 0; ai < 2; ++ai)
#pragma unroll
            for (int m = 0; m < 4; ++m) { const int row = row0 + ai * HALF + m * 16; const size_t off = (size_t)row * 1024 + col0; float ss = 0.f;
#pragma unroll
                for (int bj = 0; bj < 2; ++bj) { const u32x4 w = pre[ai][m][bj];
                    const f32x4 o0 = (f32x4){bflo(w[0]), bfhi(w[0]), bflo(w[1]), bfhi(w[1])} + acc[ai][bj][m][0], o1 = (f32x4){bflo(w[2]), bfhi(w[2]), bflo(w[3]), bfhi(w[3])} + acc[ai][bj][m][1];
                    if (fout) { *(f32x4*)(fout + off + bj * HALF) = o0; *(f32x4*)(fout + off + bj * HALF + 4) = o1; }
                    else *(u32x4*)(xb + off + bj * HALF) = pack8(o0, o1);
                    if (x8) { u32x2 q8; q8.x = pk4_fp8(o0); q8.y = pk4_fp8(o1); *(u32x2*)(x8 + off + bj * HALF) = q8; }
                    if (!fout) ss += ((o0[0] * o0[0] + o0[1] * o0[1]) + (o0[2] * o0[2] + o0[3] * o0[3])) + ((o1[0] * o1[0] + o1[1] * o1[1]) + (o1[2] * o1[2] + o1[3] * o1[3])); }
                if (!fout) { ss += __shfl_xor(ss, 16); ss += __shfl_xor(ss, 32);
                    if (fq == 0) ssq[(size_t)row * 16 + u.pn * 4 + wc] = ss; } }
    }
};
struct EpiBranch {
    static constexpr bool PERM = true, HAS_MID = true;
    unsigned char* ws;
    static __device__ __forceinline__ float gq(unsigned w, int e) { return (float)((w >> (8 * e)) & 0xffu); }
    static __device__ __forceinline__ float gbc(unsigned w, int e) { return fmaxf(gq(w, e), 0.5f); }
    __device__ __forceinline__ void mid(f32x4 (&acc)[2][2][4][2], const Unit& u, int wr, int wc, int fr, int fq) const {
        const int row0 = opaque_i(u.pm * BM + wr * 64 + fr), col0 = opaque_i(u.pn * BM + wc * 32 + 8 * fq);
        u32x2 a[2][4][2], b[2][4][2];
#pragma unroll
        for (int ai = 0; ai < 2; ++ai)
#pragma unroll
            for (int m = 0; m < 4; ++m) { const unsigned char* gp = ws + WS_GT + (size_t)(row0 + ai * HALF + m * 16) * 2048 + col0;
#pragma unroll
                for (int bj = 0; bj < 2; ++bj) { a[ai][m][bj] = *(const u32x2*)(gp + bj * HALF); b[ai][m][bj] = *(const u32x2*)(gp + 1024 + bj * HALF); } }
#pragma unroll
        for (int ai = 0; ai < 2; ++ai)
#pragma unroll
            for (int m = 0; m < 4; ++m)
#pragma unroll
                for (int bj = 0; bj < 2; ++bj)
#pragma unroll
                    for (int n = 0; n < 2; ++n)
#pragma unroll
                        for (int e = 0; e < 4; ++e) acc[ai][bj][m][n][e] *= gq(a[ai][m][bj][n], e) * __builtin_amdgcn_rcpf(gbc(b[ai][m][bj][n], e));
    }
    __device__ __forceinline__ void operator()(const f32x4 (&acc)[2][2][4][2], const Unit& u, int wr, int wc, int fr, int fq) const {
        const int row0 = u.pm * BM + wr * 64 + fr, col0 = u.pn * BM + wc * 32 + 8 * fq;
        u32x2 b[2][4][2];
#pragma unroll
        for (int ai = 0; ai < 2; ++ai)
#pragma unroll
            for (int m = 0; m < 4; ++m) { const unsigned char* gp = ws + WS_GT + (size_t)(row0 + ai * HALF + m * 16) * 2048 + 1024 + col0;
#pragma unroll
                for (int bj = 0; bj < 2; ++bj) b[ai][m][bj] = *(const u32x2*)(gp + bj * HALF); }
#pragma unroll
        for (int ai = 0; ai < 2; ++ai)
#pragma unroll
            for (int m = 0; m < 4; ++m) { bf16_t* rowp = (bf16_t*)(ws + WS_MIX) + (size_t)(row0 + ai * HALF + m * 16) * 1024 + col0;
#pragma unroll
                for (int bj = 0; bj < 2; ++bj) { f32x4 v0 = acc[ai][bj][m][0], v1 = acc[ai][bj][m][1];
#pragma unroll
                    for (int e = 0; e < 4; ++e) { v0[e] *= gbc(b[ai][m][bj][0], e) * (1.0f / 255.0f); v1[e] *= gbc(b[ai][m][bj][1], e) * (1.0f / 255.0f); }
                    *(u32x4*)(rowp + bj * HALF) = pack8(v0, v1); } }
    }
};

template <class Epi, class Sched, bool ALIGN_EPI = false, bool SP2 = false, bool ATILED = false, bool F8 = false>
__device__ __forceinline__ void gemm_phase(PG8_LAS unsigned char* lds, const Gemm g, const Sched& S, const Epi& E) {
    const int tid = opaque_i(threadIdx.x), wid = __builtin_amdgcn_readfirstlane(tid >> 6), lane = tid & 63, wr = wid >> 2, wc = wid & 3, fr = lane & 15, fq = lane >> 4;
    const int K = g.K, nt = K / BK;
    unsigned voffA[2], voffB[2];
#pragma unroll
    for (int i = 0; i < 2; ++i) { int R, C; stage_rc(tid * 16 + i * 8192, R, C); const int Rb = Epi::PERM ? ((R & ~31) + perm32(R & 31)) : R;
        voffA[i] = ATILED ? (unsigned)(R * 64 + C) * 2u : (unsigned)(R * K + C) * 2u; voffB[i] = (unsigned)(Rb * K + C) * 2u; }
    const size_t kstep = (size_t)(BK * 2);
    const size_t hstep = (size_t)HALF * K * 2;
    const size_t tstep = 2 * hstep;
    const size_t kstepA = ATILED ? (size_t)(256 * 64 * 2) : kstep, hstepA = ATILED ? (size_t)(HALF * 64 * 2) : hstep;
    const unsigned ldsw = (unsigned)wid * 1024u;
    const int aoff = lds_byte(wr * 64 + fr, fq * 8), boff = lds_byte(wc * 32 + fr, fq * 8);
#define PG8_SA(b, h) (((b) * 2 + (h)) * HTB)
#define PG8_SB(b, h) ((4 + (b) * 2 + (h)) * HTB)
#define PG8_STAGE(bufoff, gbase, voff) do { _Pragma("unroll") for (int _i = 0; _i < 2; ++_i) { unsigned vo_ = (voff)[_i]; \
        if constexpr (F8) { int R_, C_; stage_rc(opaque_i(tid) * 16 + _i * 8192, R_, C_); const bool isb_ = (&(voff)[0] == &voffB[0]); const int Rb_ = (isb_ && Epi::PERM) ? ((R_ & ~31) + perm32(R_ & 31)) : R_; vo_ = (unsigned)(Rb_ * K + C_) * 2u; } \
        __builtin_amdgcn_global_load_lds((const unsigned*)((const char*)(gbase) + vo_), (PG8_LAS unsigned*)(lds + (bufoff) + ldsw + _i * 8192), 16, 0, 0); } } while (0)
#define PG8_LDA(dst, b, h) do { _Pragma("unroll") for (int m = 0; m < 4; ++m) _Pragma("unroll") for (int k = 0; k < 2; ++k) dst[m][k] = *(const PG8_LAS bf16x8*)(lds + PG8_SA(b, h) + aoff + m * 2048 + k * 1024); } while (0)
#define PG8_LDB(dst, b, h) do { _Pragma("unroll") for (int n = 0; n < 2; ++n) _Pragma("unroll") for (int k = 0; k < 2; ++k) dst[n][k] = *(const PG8_LAS bf16x8*)(lds + PG8_SB(b, h) + boff + n * 2048 + k * 1024); } while (0)
#define PG8_MMA(ai, bj, At, Bt) do { __builtin_amdgcn_s_setprio(1); \
        if constexpr (F8) { _Pragma("unroll") for (int m = 0; m < 4; ++m) _Pragma("unroll") for (int n = 0; n < 2; ++n) \
            acc[ai][bj][m][n] = __builtin_amdgcn_mfma_scale_f32_16x16x128_f8f6f4(cat8(Bt[n][0], Bt[n][1]), cat8(At[m][0], At[m][1]), acc[ai][bj][m][n], 0, 0, 0, 0, 0, 0); } \
        else { _Pragma("unroll") for (int m = 0; m < 4; ++m) _Pragma("unroll") for (int n = 0; n < 2; ++n) _Pragma("unroll") for (int k = 0; k < 2; ++k) \
            acc[ai][bj][m][n] = __builtin_amdgcn_mfma_f32_16x16x32_bf16(Bt[n][k], At[m][k], acc[ai][bj][m][n], 0, 0, 0); } \
        __builtin_amdgcn_s_setprio(0); } while (0)
#define PG8_WAIT_V(n) asm volatile("s_waitcnt vmcnt(" #n ")" ::: "memory")
#define PG8_WAIT_L(n) asm volatile("s_waitcnt lgkmcnt(" #n ")" ::: "memory")
#define PG8_BAR __builtin_amdgcn_s_barrier()
#define PG8_SCHED __builtin_amdgcn_sched_barrier(0)
    Unit cur, nxt; int ui = 0;
    if (!S.next(0, cur)) return;
    f32x4 acc[2][2][4][2];
#pragma unroll
    for (int a = 0; a < 2; ++a)
#pragma unroll
        for (int b = 0; b < 2; ++b)
#pragma unroll
            for (int m = 0; m < 4; ++m)
#pragma unroll
                for (int n = 0; n < 2; ++n) acc[a][b][m][n] = (f32x4){0.f, 0.f, 0.f, 0.f};
    bf16x8 At[4][2], B0[2][2], B1[2][2];
    const char* cA = (const char*)g.A + (size_t)cur.pm * tstep; const char* cB = (const char*)g.Bt + (size_t)cur.pn * tstep;
    S.a_ready(cur);
    if constexpr (SP2) {
        PG8_STAGE(PG8_SB(0, 0), cB, voffB); PG8_STAGE(PG8_SB(0, 1), cB + hstep, voffB); PG8_STAGE(PG8_SA(0, 0), cA, voffA); PG8_STAGE(PG8_SA(0, 1), cA + hstepA, voffA);
        if (wr == 1) PG8_BAR;
        PG8_WAIT_V(2); PG8_BAR;
        PG8_STAGE(PG8_SB(1, 0), cB + kstep, voffB); PG8_STAGE(PG8_SA(1, 0), cA + kstepA, voffA); PG8_STAGE(PG8_SB(1, 1), cB + hstep + kstep, voffB);
        PG8_WAIT_V(6); PG8_BAR;
    } else {
        PG8_STAGE(PG8_SB(0, 0), cB, voffB); PG8_STAGE(PG8_SA(0, 0), cA, voffA); PG8_STAGE(PG8_SB(0, 1), cB + hstep, voffB); PG8_STAGE(PG8_SA(0, 1), cA + hstepA, voffA);
        if (wr == 1) PG8_BAR;
        PG8_WAIT_V(4); PG8_BAR;
        PG8_STAGE(PG8_SB(1, 0), cB + kstep, voffB); PG8_STAGE(PG8_SA(1, 0), cA + kstepA, voffA); PG8_STAGE(PG8_SB(1, 1), cB + hstep + kstep, voffB);
        PG8_WAIT_V(6); PG8_BAR;
    }
    for (;;) {
        const bool has_next = S.next(ui + 1, nxt);
        const char* nA = has_next ? (const char*)g.A + (size_t)nxt.pm * tstep : cA; const char* nB = has_next ? (const char*)g.Bt + (size_t)nxt.pn * tstep : cB;
#pragma clang loop unroll(disable)
        for (int t = 0; t < nt; t += 2) {
            const bool last = (t == nt - 2);
            const char* a1 = cA + (size_t)(t + 1) * kstepA;
            const char* a2 = last ? nA : cA + (size_t)(t + 2) * kstepA; const char* b2 = last ? nB : cB + (size_t)(t + 2) * kstep;
            const char* a3 = a2 + kstepA; const char* b3 = b2 + kstep;
            if (last && has_next) S.a_ready(nxt);
            if constexpr (SP2) {
            PG8_LDB(B0, 0, 0); PG8_LDB(B1, 0, 1); PG8_SCHED; PG8_LDA(At, 0, 0); PG8_STAGE(PG8_SA(1, 1), a1 + hstepA, voffA);
            PG8_WAIT_V(8); PG8_WAIT_L(0); PG8_BAR; PG8_MMA(0, 0, At, B0); PG8_MMA(0, 1, At, B1); PG8_BAR; PG8_SCHED;
            PG8_LDA(At, 0, 1); PG8_STAGE(PG8_SB(0, 0), b2, voffB); PG8_STAGE(PG8_SB(0, 1), b2 + hstep, voffB); PG8_STAGE(PG8_SA(0, 0), a2, voffA);
            PG8_WAIT_V(8); PG8_WAIT_L(0); PG8_BAR; PG8_MMA(1, 0, At, B0); PG8_MMA(1, 1, At, B1); PG8_BAR; PG8_SCHED;
            PG8_LDB(B0, 1, 0); PG8_LDB(B1, 1, 1); PG8_SCHED; PG8_LDA(At, 1, 0); PG8_STAGE(PG8_SA(0, 1), a2 + hstepA, voffA);
            PG8_WAIT_V(8); PG8_WAIT_L(0); PG8_BAR; PG8_MMA(0, 0, At, B0); PG8_MMA(0, 1, At, B1); PG8_BAR; PG8_SCHED;
            PG8_LDA(At, 1, 1); PG8_STAGE(PG8_SB(1, 0), b3, voffB); PG8_STAGE(PG8_SB(1, 1), b3 + hstep, voffB); PG8_STAGE(PG8_SA(1, 0), a3, voffA);
            PG8_WAIT_V(8); PG8_WAIT_L(0); PG8_BAR; PG8_MMA(1, 0, At, B0); PG8_MMA(1, 1, At, B1); PG8_BAR; PG8_SCHED;
            } else {
            PG8_LDB(B0, 0, 0); PG8_SCHED; PG8_LDA(At, 0, 0); PG8_STAGE(PG8_SA(1, 1), a1 + hstepA, voffA);
            PG8_WAIT_L(8); PG8_BAR; PG8_WAIT_L(0); PG8_MMA(0, 0, At, B0); PG8_BAR; PG8_SCHED;
            PG8_LDB(B1, 0, 1); PG8_STAGE(PG8_SB(0, 0), b2, voffB);
            PG8_BAR; PG8_WAIT_L(0); PG8_MMA(0, 1, At, B1); PG8_BAR;
            PG8_LDA(At, 0, 1); PG8_STAGE(PG8_SA(0, 0), a2, voffA);
            PG8_BAR; PG8_WAIT_L(0); PG8_MMA(1, 0, At, B0); PG8_BAR; PG8_SCHED;
            PG8_STAGE(PG8_SB(0, 1), b2 + hstep, voffB);
            PG8_WAIT_V(6); PG8_BAR; PG8_MMA(1, 1, At, B1); PG8_BAR;
            PG8_LDB(B0, 1, 0); PG8_SCHED; PG8_LDA(At, 1, 0); PG8_STAGE(PG8_SA(0, 1), a2 + hstepA, voffA);
            PG8_WAIT_L(8); PG8_BAR; PG8_WAIT_L(0); PG8_MMA(0, 0, At, B0); PG8_BAR; PG8_SCHED;
            PG8_LDB(B1, 1, 1); PG8_STAGE(PG8_SB(1, 0), b3, voffB);
            PG8_BAR; PG8_WAIT_L(0); PG8_MMA(0, 1, At, B1); PG8_BAR;
            PG8_LDA(At, 1, 1); PG8_STAGE(PG8_SA(1, 0), a3, voffA);
            PG8_BAR; PG8_WAIT_L(0); PG8_MMA(1, 0, At, B0); PG8_BAR; PG8_SCHED;
            PG8_STAGE(PG8_SB(1, 1), b3 + hstep, voffB);
            PG8_WAIT_V(6); PG8_BAR; PG8_MMA(1, 1, At, B1); PG8_BAR;
            }
            if constexpr (Epi::HAS_MID) { if (t == nt / 2 - 2) E.mid(acc, cur, wr, wc, fr, fq); }
        }
        if constexpr (ALIGN_EPI) { if (wr == 0) PG8_BAR; }
        E(acc, cur, wr, wc, fr, fq);
        if (!has_next) break;
#pragma unroll
        for (int a = 0; a < 2; ++a)
#pragma unroll
            for (int b = 0; b < 2; ++b)
#pragma unroll
                for (int m = 0; m < 4; ++m)
#pragma unroll
                    for (int n = 0; n < 2; ++n) acc[a][b][m][n] = (f32x4){0.f, 0.f, 0.f, 0.f};
        cur = nxt; cA = nA; cB = nB; ++ui;
        if constexpr (ALIGN_EPI) { if (wr == 1) PG8_BAR; }
    }
    PG8_WAIT_V(0);
    if constexpr (!ALIGN_EPI) { if (wr == 0) PG8_BAR; }
    PG8_BAR;
#undef PG8_SA
#undef PG8_SB
#undef PG8_STAGE
#undef PG8_LDA
#undef PG8_LDB
#undef PG8_MMA
#undef PG8_WAIT_V
#undef PG8_WAIT_L
#undef PG8_BAR
#undef PG8_SCHED
}
}
constexpr int RING_OFF = 0, RING_BYTES = 131072;
constexpr int LDSCTL_OFF = RING_BYTES, MISC_OFF = LDSCTL_OFF + 320;
constexpr int RSTD_LDS_OFF = 135168, LDS_BYTES = 155648;

#define GAS __attribute__((address_space(1)))
#define LAS __attribute__((address_space(3)))
typedef unsigned short bf16;
typedef unsigned v4u __attribute__((ext_vector_type(4)));
typedef unsigned v2u __attribute__((ext_vector_type(2)));
typedef float f32x4 __attribute__((ext_vector_type(4)));
typedef float f32x16 __attribute__((ext_vector_type(16)));
typedef short bf16x8 __attribute__((ext_vector_type(8)));
typedef GAS unsigned gu32;
#define RLX_AGENT __ATOMIC_RELAXED, __HIP_MEMORY_SCOPE_AGENT
#define LDS_WAIT() asm volatile("s_waitcnt lgkmcnt(0)" ::: "memory")
#define VM_WAIT() asm volatile("s_waitcnt vmcnt(0)" ::: "memory")
typedef float f32x2_t __attribute__((ext_vector_type(2))); typedef __bf16 bf16x2_t __attribute__((ext_vector_type(2)));
__device__ __forceinline__ unsigned pk2(float lo, float hi) { f32x2_t v = {lo, hi}; bf16x2_t b = __builtin_convertvector(v, bf16x2_t); return __builtin_bit_cast(unsigned, b); }
__device__ __forceinline__ float bf2f(bf16 v) { return __uint_as_float((unsigned)v << 16); }
__device__ __forceinline__ bf16 f2bf(float f) { return (bf16)(pk2(f, 0.f) & 0xffffu); }
__device__ __forceinline__ int pi32(int r) { return (r & ~12) | ((r & 4) << 1) | ((r & 8) >> 1); }
__device__ __forceinline__ int crow(int r, int hi) { return (r & 3) + 8 * (r >> 2) + 4 * hi; }
__device__ __forceinline__ float wave_sum(float v) {
#pragma unroll
    for (int o = 1; o < 64; o <<= 1) v += __shfl_xor(v, o);
    return v;
}
__device__ __forceinline__ float wave_max(float v) {
#pragma unroll
    for (int o = 1; o < 64; o <<= 1) v = fmaxf(v, __shfl_xor(v, o));
    return v;
}
__device__ __forceinline__ bf16x8 pack_frag(float a0, float a1, float a2, float a3, float a4, float a5, float a6, float a7) {
    v4u w; w.x = pk2(a0, a1); w.y = pk2(a2, a3); w.z = pk2(a4, a5); w.w = pk2(a6, a7); return __builtin_bit_cast(bf16x8, w);
}
#define MFMA32(a, b, c) __builtin_amdgcn_mfma_f32_32x32x16_bf16((a), (b), (c), 0, 0, 0)

#define XB_TMO      128
#define XB_XCNT(j)  (256  + 64 * (j))
#define XB_XSUB(j)  (1280 + 64 * (j))
#define XB_XGEN(j)  (2304 + 64 * (j))
#define XB_TOP      3328
#define XB_TOPGEN   3392
#define XCD_BAR_WORDS 3456
#define XB_SPIN_CAP (1u << 18)

__device__ __forceinline__ unsigned xb_ld(unsigned* p)              { return __hip_atomic_load(p, __ATOMIC_RELAXED, __HIP_MEMORY_SCOPE_AGENT); }
__device__ __forceinline__ unsigned xb_add(unsigned* p, unsigned v) { return __hip_atomic_fetch_add(p, v, __ATOMIC_RELAXED, __HIP_MEMORY_SCOPE_AGENT); }
__device__ __forceinline__ unsigned xb_xcc_id() { return (unsigned)__builtin_amdgcn_s_getreg((3 << 11) | 20) & 0xFu; }
#define XB_SPIN(cond, bar) do { unsigned _sp = 0; while (cond) { __builtin_amdgcn_s_sleep(1); \
    if ((++_sp & 255u) == 0u) { if (xb_ld(&(bar)[XB_TMO])) break; if (_sp > XB_SPIN_CAP) { atomicAdd(&(bar)[XB_TMO], 1u); break; } } } } while (0)

struct XcdBarrier {
    unsigned* bar; unsigned x;
    volatile LAS unsigned* st;
};

__device__ __forceinline__ XcdBarrier xcd_barrier_post(unsigned* bar, volatile LAS unsigned* st) {
    XcdBarrier b; b.bar = bar; b.x = xb_xcc_id(); b.st = st;
    if (threadIdx.x == 0) (void)xb_add(&bar[XB_XCNT(b.x)], 1u);
    return b;
}
__device__ __forceinline__ void xcd_barrier_complete(unsigned* bar, unsigned x, unsigned& nloc, unsigned& nx) {
    const unsigned G = gridDim.x * gridDim.y * gridDim.z;
    unsigned sum, cnt, mine, sp = 0u;
    for (;;) {
        sum = 0u; cnt = 0u; mine = 0u;
#pragma unroll
        for (unsigned j = 0; j < 16; ++j) { const unsigned c = xb_ld(&bar[XB_XCNT(j)]); sum += c; cnt += (c > 0u) ? 1u : 0u; mine = (j == x) ? c : mine; }
        if (sum == G) break;
        __builtin_amdgcn_s_sleep(1);
        if ((++sp & 255u) == 0u) { if (xb_ld(&bar[XB_TMO])) break; if (sp > XB_SPIN_CAP) { atomicAdd(&bar[XB_TMO], 1u); break; } }
    }
    nloc = mine > 0u ? mine : 1u; nx = cnt > 0u ? cnt : 1u;
}

__device__ __forceinline__ void xcd_barrier(const XcdBarrier& b, bool release = true) {
    asm volatile("s_waitcnt vmcnt(0)" ::: "memory");
    __syncthreads();
    if (threadIdx.x == 0) {
        unsigned* bar = b.bar;
        __builtin_amdgcn_s_waitcnt(0);
        unsigned nloc = b.st[0], nx = b.st[1];
        if (nloc == 0u) { xcd_barrier_complete(bar, b.x, nloc, nx); b.st[0] = nloc; b.st[1] = nx; }
        const unsigned old = xb_add(&bar[XB_XSUB(b.x)], 1u);
        const unsigned gen = old / nloc;
        if (old + 1u == (gen + 1u) * nloc) {
            if (release) __builtin_amdgcn_fence(__ATOMIC_RELEASE, "agent");
            asm volatile("s_waitcnt vmcnt(0)" ::: "memory");
            if (release) {
            const unsigned og = xb_add(&bar[XB_TOP], 1u);
            const unsigned tg = og / nx;
            if (og + 1u == (tg + 1u) * nx) xb_add(&bar[XB_TOPGEN], 1u);
            else XB_SPIN(xb_ld(&bar[XB_TOPGEN]) == tg, bar);
            }
            __builtin_amdgcn_fence(__ATOMIC_ACQUIRE, "agent");
            xb_add(&bar[XB_XGEN(b.x)], 1u);
            asm volatile("s_waitcnt vmcnt(0)" ::: "memory");
        } else {
            XB_SPIN(xb_ld(&bar[XB_XGEN(b.x)]) == gen, bar);
            __builtin_amdgcn_fence(__ATOMIC_ACQUIRE, "agent");
            asm volatile("s_waitcnt vmcnt(0)" ::: "memory");
        }
    }
    __syncthreads();
}


__device__ __forceinline__ void head_group_sync(unsigned* cnt, unsigned* tmo, unsigned target = 8u) {
    asm volatile("s_waitcnt vmcnt(0)" ::: "memory");
    __syncthreads();
    if (threadIdx.x == 0) {
        __hip_atomic_fetch_add(cnt, 1u, __ATOMIC_RELAXED, __HIP_MEMORY_SCOPE_AGENT);
        unsigned sp = 0; while (xb_ld(cnt) < target) { __builtin_amdgcn_s_sleep(1); if ((++sp & 255u) == 0u) { if (xb_ld(tmo)) break; if (sp > XB_SPIN_CAP) { atomicAdd(tmo, 1u); break; } } }
        __builtin_amdgcn_fence(__ATOMIC_ACQUIRE, "agent");
        asm volatile("s_waitcnt vmcnt(0)" ::: "memory");
    }
    __syncthreads();
}

struct Args {
    const float* x; const float* norm_mix; const float* w_in; const float* a_q_norm; const float* a_k_norm; const float* lq1; const float* lk1; const float* lq2; const float* lk2;
    const float* a_sub_norm; const float* b_gate_up; const float* b_gate_bias; const float* b_out_norm; const float* w_branch; const float* w_out; const float* norm_ffn; const float* w_up; const float* w_down;
    float* out; unsigned char* ws; float lam_init[4]; int ph_lo, ph_hi;
};
struct Frame {
    LAS unsigned char* lds; unsigned char* ldsg;
    int tid, lane, wave;
    int x, r, nl, xr;
};
__device__ __forceinline__ Frame make_frame(unsigned char* lds) {
    Frame F; F.lds = (LAS unsigned char*)lds; F.ldsg = lds;
    F.tid = pg8::opaque_i(threadIdx.x); F.lane = F.tid & 63; F.wave = __builtin_amdgcn_readfirstlane(F.tid >> 6);
    const volatile LAS unsigned* M = (const volatile LAS unsigned*)(F.lds + pg8::opaque_i(MISC_OFF));
    F.xr = __builtin_amdgcn_readfirstlane((int)M[16]); F.x = 0; F.r = __builtin_amdgcn_readfirstlane((int)M[17]); F.nl = __builtin_amdgcn_readfirstlane((int)M[18]);
    return F;
}
template <int NN, bool TMODE, int SKIP = 1 << 20> struct XcdOrder {
    int x, r, nl;
    __device__ __forceinline__ bool next(int i, pg8::Unit& u) const {
        const int k = r + i * nl;
        if (!TMODE) { if (k >= 16 * NN) return false; const int g = k / (8 * NN), rem = k - g * (8 * NN); u.pm = 16 * x + 8 * g + (rem & 7); u.pn = rem >> 3; if (u.pn >= SKIP) ++u.pn; }
        else { if (k >= 16 * NN) return false; const int g = k / (8 * NN), rem = k - g * (8 * NN); u.pn = 16 * x + 8 * g + (rem & 7); u.pm = rem >> 3; }
        return true;
    }
    __device__ __forceinline__ void a_ready(const pg8::Unit&) const {}
    __device__ __forceinline__ void done(const pg8::Unit&) const {}
};

__device__ __forceinline__ void conv_store(LAS float* scr, bf16* WT, int ldt, int row0, int k0, int lane) {
    LDS_WAIT(); asm volatile("" ::: "memory");
    const int c = lane & 7;
#pragma unroll
    for (int j = 0; j < 4; ++j) { const int n = (lane >> 3) + 8 * j; const LAS float* s = scr + (8 * c) * 33 + n;
        v4u o; o.x = pk2(s[0 * 33], s[1 * 33]); o.y = pk2(s[2 * 33], s[3 * 33]); o.z = pk2(s[4 * 33], s[5 * 33]); o.w = pk2(s[6 * 33], s[7 * 33]);
        *(GAS v4u*)(WT + (size_t)(row0 + n) * ldt + k0 + 8 * c) = o; }
    LDS_WAIT(); asm volatile("" ::: "memory");
}
__device__ __forceinline__ void conv_item8(const float* W, int ldw, int col0, int k0, const float* gain, unsigned char* W8, int row0, LAS float* scr, int lane) {
    f32x4 v[8]; float gk[8]; const int kq = lane >> 3, n4 = (lane & 7) * 4;
#pragma unroll
    for (int i = 0; i < 8; ++i) { const int kk = kq + 8 * i; v[i] = *(const f32x4*)(W + (size_t)(k0 + kk) * ldw + col0 + n4); gk[i] = gain[k0 + kk] * 32.0f; }
#pragma unroll
    for (int i = 0; i < 8; ++i) { const int kk = kq + 8 * i; LAS float* s = scr + kk * 33 + n4; s[0] = v[i][0] * gk[i]; s[1] = v[i][1] * gk[i]; s[2] = v[i][2] * gk[i]; s[3] = v[i][3] * gk[i]; }
    LDS_WAIT(); asm volatile("" ::: "memory");
    const int c = lane & 7;
#pragma unroll
    for (int j = 0; j < 4; ++j) { const int n = (lane >> 3) + 8 * j; const LAS float* s = scr + (8 * c) * 33 + n;
        v2u o; o.x = pg8::pk4_fp8((f32x4){s[0 * 33], s[1 * 33], s[2 * 33], s[3 * 33]}); o.y = pg8::pk4_fp8((f32x4){s[4 * 33], s[5 * 33], s[6 * 33], s[7 * 33]});
        *(GAS v2u*)(W8 + (size_t)(row0 + n) * DM + k0 + 8 * c) = o; }
    LDS_WAIT(); asm volatile("" ::: "memory");
}
__device__ __forceinline__ void conv_item(const float* W, int ldw, int col0, int k0, const float* gain, bf16* WT, int ldt, int row0, LAS float* scr, int lane) {
    f32x4 v[8]; float gk[8]; const int kq = lane >> 3, n4 = (lane & 7) * 4;
#pragma unroll
    for (int i = 0; i < 8; ++i) { const int kk = kq + 8 * i; v[i] = *(const f32x4*)(W + (size_t)(k0 + kk) * ldw + col0 + n4); gk[i] = gain ? gain[k0 + kk] : 1.f; }
#pragma unroll
    for (int i = 0; i < 8; ++i) { const int kk = kq + 8 * i; LAS float* s = scr + kk * 33 + n4; s[0] = v[i][0] * gk[i]; s[1] = v[i][1] * gk[i]; s[2] = v[i][2] * gk[i]; s[3] = v[i][3] * gk[i]; }
    conv_store(scr, WT, ldt, row0, k0, lane);
}
__device__ __forceinline__ void conv_item_z(const float* Win, const float* Wgu, int c0, int k0, const float* gain, bf16* WT, int row0, LAS float* scr, int lane) {
    float gu[16];
#pragma unroll
    for (int r = 0; r < 16; ++r) gu[r] = Wgu[r * 256 + c0 + (lane & 31)];
#pragma unroll 4
    for (int i = 0; i < 32; ++i) { const int kk = 2 * i + (lane >> 5); const float* wr_ = Win + (size_t)(k0 + kk) * DIN + C_BA; float v = 0.f;
#pragma unroll
        for (int r = 0; r < 16; ++r) v += wr_[r] * gu[r];
        scr[kk * 33 + (lane & 31)] = v * gain[k0 + kk]; }
    conv_store(scr, WT, DM, row0, k0, lane);
}
__device__ __forceinline__ void p0_weights(Frame& F, const Args& a) {
    const int gw = (int)blockIdx.x * NWAVES + F.wave, NGW = (int)gridDim.x * NWAVES;
    if (blockIdx.x < DEPTH && F.wave == 0) {
        const int l = blockIdx.x; float* par = (float*)(a.ws + WS_PAR + (size_t)l * PAR_LAYER_BYTES); const int lane = F.lane;
        par[PAR_QG + lane] = a.a_q_norm[l * 64 + lane]; par[PAR_KG + lane] = a.a_k_norm[l * 64 + lane];
#pragma unroll
        for (int i = 0; i < 4; ++i) par[PAR_ZB + 64 * i + lane] = a.b_gate_bias[l * 256 + 64 * i + lane];
#pragma unroll
        for (int i = 0; i < 2; ++i) { par[PAR_SUB + 64 * i + lane] = a.a_sub_norm[l * 128 + 64 * i + lane]; par[PAR_OUTG + 64 * i + lane] = a.b_out_norm[l * 128 + 64 * i + lane]; }
        const float p1 = wave_sum(a.lq1[l * 64 + lane] * a.lk1[l * 64 + lane]), p2 = wave_sum(a.lq2[l * 64 + lane] * a.lk2[l * 64 + lane]);
        const float gq = wave_max(fabsf(a.a_q_norm[l * 64 + lane])), gk = wave_max(fabsf(a.a_k_norm[l * 64 + lane]));
        if (lane == 0) { par[PAR_LAM] = __expf(p1) - __expf(p2) + a.lam_init[l]; par[PAR_NEGB] = -(64.f * gq * gk * 0.125f * 1.4426950408889634f); par[PAR_ONEM] = 1.f - a.lam_init[l]; }
    }
    LAS float* scr = (LAS float*)(F.lds + RING_OFF + F.wave * 16384);
    constexpr int I_N = (NIN_N / 32) * 16, I_T = (NIN_T / 32) * 16, I_BR = 32 * 16, I_OUT = 32 * 16, I_UP = 128 * 16, I_DN = 32 * 64;
    constexpr int NITEMS = I_N + I_T + I_BR + I_OUT + I_UP + I_DN;
    for (int itg = gw; itg < DEPTH * NITEMS; itg += NGW) {
        const int l = itg / NITEMS; int r = itg - l * NITEMS; const int lane_ = pg8::opaque_i(F.lane);
        const float* Win = a.w_in + (size_t)l * DM * DIN; const float* gmix = a.norm_mix + l * DM; const float* Wgu = a.b_gate_up + (size_t)l * 16 * 256;
        unsigned char* wl = a.ws + WS_W0 + (size_t)l * W_LAYER; bf16* WN = (bf16*)(wl + WO_IN_N); bf16* WTt = (bf16*)(wl + WO_IN_T);
        if (r < I_N) { const int nb = r % (NIN_N / 32), kb = r / (NIN_N / 32), tile = nb >> 3, jb = nb & 7, foff = 64 * (jb & 3) + 32 * (jb >> 2), row0 = tile * 256 + 32 * jb;
            if (tile == 6) {
                if (jb == 0) { const int k = kb * 64 + lane_; const float gk_ = gmix[k]; const float* wr_ = Win + (size_t)k * DIN + C_BA; bf16* wb = (bf16*)(wl + WO_ZBA);
#pragma unroll
                    for (int r_ = 0; r_ < 16; ++r_) wb[r_ * DM + k] = f2bf(wr_[r_] * gk_); }
                else if (jb == 1 && kb == 0) { bf16* wu = (bf16*)(wl + WO_ZUP);
#pragma unroll
                    for (int c4 = 0; c4 < 4; ++c4) { const int c_ = 4 * lane_ + c4;
#pragma unroll
                        for (int r_ = 0; r_ < 16; ++r_) wu[c_ * 16 + r_] = f2bf(Wgu[r_ * 256 + c_]); } }
                continue; }
            const int col0 = (tile < 2 ? C_AQ + tile * 256 : tile < 4 ? C_AK + (tile - 2) * 256 : tile == 4 ? C_BQ : tile == 5 ? C_BK : tile < 9 ? C_BR + (tile - 7) * 256 : C_GT + (tile - 9) * 256) + foff;
            if (tile >= 9) { conv_item8(Win, DIN, col0, kb * 64, gmix, wl + WO_IN_G8, row0 - 9 * 256, scr, lane_); continue; }
            conv_item(Win, DIN, col0, kb * 64, gmix, WN, DM, row0, scr, lane_); continue; }
        r -= I_N;
        if (r < I_T) { const int rb = r % (NIN_T / 32), kb = r / (NIN_T / 32), f0 = rb * 32;
            const int col0 = f0 < 512 ? C_AV + f0 : C_BV + (f0 - 512);
            conv_item(Win, DIN, col0, kb * 64, gmix, WTt, DM, f0, scr, lane_); continue; }
        r -= I_T;
        if (r < I_BR) { conv_item(a.w_branch + (size_t)l * DM * DM, DM, (r & 31) * 32, (r >> 5) * 64, nullptr, (bf16*)(wl + WO_BR), DM, (r & 31) * 32, scr, lane_); continue; }
        r -= I_BR;
        if (r < I_OUT) { conv_item(a.w_out + (size_t)l * DM * DM, DM, (r & 31) * 32, (r >> 5) * 64, nullptr, (bf16*)(wl + WO_OUT), DM, (r & 31) * 32, scr, lane_); continue; }
        r -= I_OUT;
        if (r < I_UP) { conv_item(a.w_up + (size_t)l * DM * DFF, DFF, (r & 127) * 32, (r >> 7) * 64, a.norm_ffn + l * DM, (bf16*)(wl + WO_UP), DM, (r & 127) * 32, scr, lane_); continue; }
        r -= I_UP;
        conv_item(a.w_down + (size_t)l * DFF * DM, DM, (r & 31) * 32, (r >> 5) * 64, nullptr, (bf16*)(wl + WO_DN), DFF, (r & 31) * 32, scr, lane_);
    }
}
__device__ __forceinline__ void p0_x(Frame& F, const Args& a, unsigned char* wsb, unsigned char* x8) {
    float* part = (float*)(wsb + WS_PARTA); bf16* XB = (bf16*)(wsb + WS_XB);
    for (int k = 2 * (F.r * NWAVES + F.wave); k < SEQ; k += 2 * F.nl * NWAVES) {
        const GAS f32x4* xr = (const GAS f32x4*)(a.x + (size_t)(F.xr * SEQ + k) * DM) + F.lane; f32x4 v[2][4]; float s[2] = {0.f, 0.f};
#pragma unroll
        for (int q = 0; q < 2; ++q)
#pragma unroll
            for (int j = 0; j < 4; ++j) v[q][j] = xr[q * (DM / 4) + 64 * j];
#pragma unroll
        for (int q = 0; q < 2; ++q) {
#pragma unroll
            for (int j = 0; j < 4; ++j) s[q] += (v[q][j].x * v[q][j].x + v[q][j].y * v[q][j].y) + (v[q][j].z * v[q][j].z + v[q][j].w * v[q][j].w);
            s[q] = wave_sum(s[q]);
            GAS v2u* o8 = (GAS v2u*)(XB + (size_t)(k + q) * DM) + F.lane;
#pragma unroll
            for (int j = 0; j < 4; ++j) { v2u w; w.x = pk2(v[q][j].x, v[q][j].y); w.y = pk2(v[q][j].z, v[q][j].w); o8[64 * j] = w; }
            GAS unsigned* o4 = (GAS unsigned*)(x8 + (size_t)(k + q) * DM) + F.lane;
#pragma unroll
            for (int j = 0; j < 4; ++j) o4[64 * j] = pg8::pk4_fp8(v[q][j]);
            if (F.lane < 4) *(f32x4*)(part + (size_t)(k + q) * 16 + 4 * F.lane) = (f32x4){F.lane == 0 ? s[q] : 0.f, 0.f, 0.f, 0.f};
        }
    }
}
typedef short bf16x4_t __attribute__((ext_vector_type(4)));
__device__ __forceinline__ float logsig16(float z) { return (fminf(z, 0.f) - __logf(1.f + __expf(-fabsf(z)))) * (1.0f / 16.0f); }
__device__ __forceinline__ void z_phase(Frame& F, unsigned char* ws, const unsigned char* wl, const float* par) {
    const bf16* XB = (const bf16*)(ws + WS_XB); const float* part = (const float*)(ws + WS_PARTA); const bf16* WBA = (const bf16*)(wl + WO_ZBA); const bf16* WUP = (const bf16*)(wl + WO_ZUP);
    bf16* GG = (bf16*)(ws + WS_GG); bf16* GTT = (bf16*)(ws + WS_GTT);
    const int lane = F.lane, c16 = lane & 15, q = lane >> 4;
    for (int it = F.r * NWAVES + F.wave; it < SEQ / 16; it += F.nl * NWAVES) {
        const int tok0 = 16 * it;
        const bf16* xrow = XB + (size_t)(tok0 + c16) * DM + 8 * q; const bf16* wrow = WBA + (size_t)c16 * DM + 8 * q;
        pg8::f32x4 acc = {0.f, 0.f, 0.f, 0.f};
#pragma unroll
        for (int ks = 0; ks < 32; ++ks) acc = __builtin_amdgcn_mfma_f32_16x16x32_bf16(*(const bf16x8*)(wrow + 32 * ks), *(const bf16x8*)(xrow + 32 * ks), acc, 0, 0, 0);
        const float rstd = rsqrtf(pg8::sum16(part + (size_t)(tok0 + c16) * 16) * (1.0f / 1024.0f) + pg8::RMS_EPS);
        v2u bw; bw.x = pk2(acc[0] * rstd, acc[1] * rstd); bw.y = pk2(acc[2] * rstd, acc[3] * rstd);
        const bf16x4_t bav = __builtin_bit_cast(bf16x4_t, bw);
#pragma unroll 4
        for (int blk = 0; blk < 16; ++blk) {
            const bf16x4_t wf = *(const bf16x4_t*)(WUP + (size_t)(16 * blk + c16) * 16 + 4 * q);
            const pg8::f32x4 zero = {0.f, 0.f, 0.f, 0.f};
            const pg8::f32x4 zt = __builtin_amdgcn_mfma_f32_16x16x16bf16_1k(bav, wf, zero, 0, 0, 0);
            const pg8::f32x4 zn = __builtin_amdgcn_mfma_f32_16x16x16bf16_1k(wf, bav, zero, 0, 0, 0);
            { const int c = 16 * blk + c16, h = c >> 6, d = c & 63, t = tok0 + 4 * q; const float bz = par[PAR_ZB + c];
              v2u o; o.x = pk2(logsig16(zt[0] + bz), logsig16(zt[1] + bz)); o.y = pk2(logsig16(zt[2] + bz), logsig16(zt[3] + bz));
              *(v2u*)(GTT + ((((size_t)h * 64 + (t >> 6)) * 64 + d) << 6) + (t & 63)) = o; }
            { const int c0 = 16 * blk + 4 * q; const pg8::f32x4 bz = *(const pg8::f32x4*)(par + PAR_ZB + c0);
              v2u o; o.x = pk2(logsig16(zn[0] + bz[0]), logsig16(zn[1] + bz[1])); o.y = pk2(logsig16(zn[2] + bz[2]), logsig16(zn[3] + bz[3]));
              *(v2u*)(GG + (size_t)(tok0 + c16) * 256 + c0) = o; }
        }
    }
}
__device__ __forceinline__ void fill_rstd_lds(Frame& F, const float* part) {
    LAS float* tbl = (LAS float*)(F.lds + RSTD_LDS_OFF);
    if (F.nl == 32) {
        const int k = ((F.tid >> 8) * 8 + (F.r & 7)) * 256 + (F.tid & 255);
        tbl[k] = rsqrtf(pg8::sum16(part + (size_t)(F.x * SEQ + k) * 16) * (1.0f / 1024.0f) + pg8::RMS_EPS);
    } else {
#pragma unroll 2
        for (int k = F.tid; k < SEQ; k += NWAVES * 64) tbl[k] = rsqrtf(pg8::sum16(part + (size_t)(F.x * SEQ + k) * 16) * (1.0f / 1024.0f) + pg8::RMS_EPS);
    }
    __syncthreads();
}

constexpr int AT_SLOT = 32768, AT_K2 = 8192, AT_V = 16384;
__device__ __forceinline__ void attn_phase(Frame& F, unsigned char* ws, const float* par, bf16* Y) {
    const bf16* Qa = (const bf16*)(ws + WS_QA); const bf16* Ka = (const bf16*)(ws + WS_KA); const bf16* Vta = (const bf16*)(ws + WS_VTA);
    const int lane = F.lane, r = lane & 31, hh = lane >> 5, w = F.wave, m = w >> 2, qs = w & 3;
    const float lam = par[PAR_LAM], negb = par[PAR_NEGB], onem = par[PAR_ONEM];
    LAS unsigned char* const L = F.lds;
    float* X = (float*)(F.ldsg);
    float* lw = (float*)(F.ldsg + 65536 + w * 128);
    bf16* stg = (bf16*)(F.ldsg + 69632 + (w & 3) * 8192);
    const int i8 = lane >> 3, i7 = lane & 7;
    const int koff = (8 * w + i8) * 512 + ((i7 ^ ((4 * w + (lane >> 4)) & 7)) * 8);
    const int voff0 = (16 * w + i8) * 64 + ((i7 ^ ((8 * w + (lane >> 4)) & 7)) * 8), voff1 = (16 * w + 8 + i8) * 64 + ((i7 ^ ((8 * w + 4 + (lane >> 4)) & 7)) * 8);
    const int rowK = pi32(r), kx = (rowK >> 1) & 7, vx = (r >> 1) & 7;
    int kfo[4], vfo[4];
#pragma unroll
    for (int j = 0; j < 4; ++j) { kfo[j] = m * AT_K2 + rowK * 128 + (((2 * j + hh) ^ kx) * 16); vfo[j] = AT_V + r * 128 + (((2 * j + hh) ^ vx) * 16); }
    if (w >= 4) __builtin_amdgcn_s_setprio(1);
    for (int ui = F.r; ui < 128; ui += F.nl) {
        const int h = ui >> 5, rr = ui & 31, r2 = (rr + 16) & 31, qblk = h == 0 ? rr : h == 1 ? 31 - rr : h == 2 ? r2 : 31 - r2, b = F.x, bh = b * 4 + h;
        const int q0 = qblk * 128 + 32 * qs, NT = 2 * qblk + 2, mynt = qs < 2 ? NT - 1 : NT; const size_t tb = (size_t)b * SEQ;
        const bf16* kbase = Ka + tb * 512 + h * 128 + koff;
        const bf16* vbase = Vta + (size_t)(bh * 64) * 8192;
#define AT_DMA(kt, slot) do { const bf16* kp_ = kbase + (size_t)(kt) * (64 * 512); const bf16* vp_ = vbase + (size_t)(kt) * 8192; LAS unsigned char* sl_ = L + (slot) * AT_SLOT + w * 1024; \
        __builtin_amdgcn_global_load_lds((const unsigned*)kp_, (LAS unsigned*)sl_, 16, 0, 0); __builtin_amdgcn_global_load_lds((const unsigned*)(kp_ + 64), (LAS unsigned*)(sl_ + AT_K2), 16, 0, 0); \
        __builtin_amdgcn_global_load_lds((const unsigned*)(vp_ + voff0), (LAS unsigned*)(sl_ + AT_V + w * 1024), 16, 0, 0); __builtin_amdgcn_global_load_lds((const unsigned*)(vp_ + voff1), (LAS unsigned*)(sl_ + AT_V + w * 1024 + 1024), 16, 0, 0); } while (0)
        AT_DMA(0, 0); AT_DMA(1, 1);
        bf16x8 qf[4];
#pragma unroll
        for (int d0 = 0; d0 < 4; ++d0) qf[d0] = *(const bf16x8*)(Qa + (tb + q0 + r) * 512 + h * 128 + m * 64 + 16 * d0 + 8 * hh);
        f32x16 o[4]; float lsum = 0.f;
#pragma unroll
        for (int eb = 0; eb < 4; ++eb)
#pragma unroll
            for (int i = 0; i < 16; ++i) o[eb][i] = 0.f;
        int slot = 0;
        for (int t = 0; t < NT; ++t) {
            if (t + 1 < NT) asm volatile("s_waitcnt vmcnt(4)" ::: "memory"); else asm volatile("s_waitcnt vmcnt(0)" ::: "memory");
            __builtin_amdgcn_s_barrier(); asm volatile("" ::: "memory");
            if (t + 2 < NT) { const int s2 = slot == 0 ? 2 : slot - 1; AT_DMA(t + 2, s2); }
            if (t < mynt) {
                LAS unsigned char* const sl = L + slot * AT_SLOT;
                f32x16 p[2];
                bf16x8 kfa[4], kfb[4];
#pragma unroll
                for (int d0 = 0; d0 < 4; ++d0) kfa[d0] = *(const LAS bf16x8*)(sl + kfo[d0]);
#pragma unroll
                for (int d0 = 0; d0 < 4; ++d0) kfb[d0] = *(const LAS bf16x8*)(sl + 4096 + kfo[d0]);
#pragma unroll
                for (int i = 0; i < 16; ++i) { p[0][i] = negb; p[1][i] = negb; }
                __builtin_amdgcn_sched_barrier(0);
#pragma unroll
                for (int d0 = 0; d0 < 4; ++d0) p[0] = MFMA32(kfa[d0], qf[d0], p[0]);
#pragma unroll
                for (int d0 = 0; d0 < 4; ++d0) p[1] = MFMA32(kfb[d0], qf[d0], p[1]);
#pragma unroll
                for (int kb = 0; kb < 2; ++kb)
#pragma unroll
                    for (int i = 0; i < 16; ++i) { p[kb][i] = __builtin_amdgcn_exp2f(p[kb][i]); lsum += p[kb][i]; }
#pragma unroll
                for (int kb = 0; kb < 2; ++kb)
#pragma unroll
                    for (int sg = 0; sg < 2; ++sg) {
                        bf16x8 vf[4];
#pragma unroll
                        for (int eb = 0; eb < 4; ++eb) vf[eb] = *(const LAS bf16x8*)(sl + eb * 4096 + vfo[2 * kb + sg]);
                        const bf16x8 pf = pack_frag(p[kb][8 * sg], p[kb][8 * sg + 1], p[kb][8 * sg + 2], p[kb][8 * sg + 3], p[kb][8 * sg + 4], p[kb][8 * sg + 5], p[kb][8 * sg + 6], p[kb][8 * sg + 7]);
#pragma unroll
                        for (int eb = 0; eb < 4; ++eb) o[eb] = MFMA32(pf, vf[eb], o[eb]);
                    }
            }
            slot = slot == 2 ? 0 : slot + 1;
        }
#undef AT_DMA
        asm volatile("s_waitcnt lgkmcnt(0)" ::: "memory"); __builtin_amdgcn_s_barrier(); asm volatile("" ::: "memory");
        lsum += __shfl_xor(lsum, 32);
        if (hh == 0) lw[r] = lsum;
        LDS_WAIT(); asm volatile("" ::: "memory");
        float inv[16];
#pragma unroll
        for (int i = 0; i < 16; ++i) inv[i] = 1.f / lw[crow(i, hh)];
        if (m == 1) {
#pragma unroll
            for (int eb = 0; eb < 4; ++eb)
#pragma unroll
                for (int i = 0; i < 16; ++i) X[((qs * 4 + eb) * 16 + i) * 64 + lane] = lam * o[eb][i] * inv[i];
        }
        __syncthreads();
        if (m == 0) {
            float ss[16];
#pragma unroll
            for (int i = 0; i < 16; ++i) ss[i] = 0.f;
#pragma unroll
            for (int eb = 0; eb < 4; ++eb)
#pragma unroll
                for (int i = 0; i < 16; ++i) { const float val = o[eb][i] * inv[i] - X[((qs * 4 + eb) * 16 + i) * 64 + lane]; o[eb][i] = val; ss[i] += val * val; }
#pragma unroll
            for (int of = 1; of < 32; of <<= 1) { float t[16];
#pragma unroll
                for (int i = 0; i < 16; ++i) t[i] = __shfl_xor(ss[i], of);
#pragma unroll
                for (int i = 0; i < 16; ++i) ss[i] += t[i]; }
#pragma unroll
            for (int i = 0; i < 16; ++i) ss[i] = rsqrtf(ss[i] * (1.0f / 128.0f) + pg8::RMS_EPS) * onem;
#pragma unroll
            for (int eb = 0; eb < 4; ++eb) { const float g = par[PAR_SUB + 32 * eb + r];
#pragma unroll
                for (int i = 0; i < 16; ++i) stg[crow(i, hh) * 128 + 32 * eb + r] = f2bf(o[eb][i] * ss[i] * g); }
            LDS_WAIT(); asm volatile("" ::: "memory");
            const int lane2 = pg8::opaque_i(lane);
#pragma unroll
            for (int jj = 0; jj < 8; ++jj) { const int row = (jj * 64 + lane2) >> 4, ch = lane2 & 15; const v4u vv = *(const v4u*)(stg + row * 128 + ch * 8);
                *(v4u*)(Y + (tb + q0 + row) * 1024 + h * 128 + ch * 8) = vv; }
        }
        __syncthreads();
    }
    __builtin_amdgcn_s_setprio(0);
}

__device__ __forceinline__ void gla_kv_phase(Frame& F, unsigned char* ws, unsigned char* kvbuf) {
    const bf16* Vtb = (const bf16*)(ws + WS_VTB); const bf16* Ktb = (const bf16*)(ws + WS_KTB); const bf16* Gtt = (const bf16*)(ws + WS_GTT);
    v2u* KV = (v2u*)kvbuf; float* DEC = (float*)(ws + WS_DEC);
    const int lane = F.lane, r = lane & 31, hh = lane >> 5;
    const bool grouped = F.nl == 32;
    for (int itl = (grouped ? (F.r & 7) : F.r) * NWAVES + F.wave; itl < (grouped ? 128 : NCH * 4 * 2); itl += (grouped ? 8 : F.nl) * NWAVES) {
        const int b = F.x, it = grouped ? (((itl >> 1) << 3) | ((F.r >> 3) << 1) | (itl & 1)) : b * 512 + itl, eh = it & 1, h = (it >> 1) & 3, n = (it >> 3) & 63; const size_t t0 = (size_t)b * SEQ + 64 * n; (void)t0;
        bf16x8 af[2][4];
#pragma unroll
        for (int db = 0; db < 2; ++db) {
            const int dl = 32 * db + pi32(r); const size_t ro = ((size_t)((b * 4 + h) * 64 + n) * 64 + dl) * 64 + 8 * hh;
            float gv[4][8]; v4u kraw[4];
#pragma unroll
            for (int s = 0; s < 4; ++s) { const v4u graw = *(const v4u*)(Gtt + ro + 16 * s); kraw[s] = *(const v4u*)(Ktb + ro + 16 * s);
#pragma unroll
                for (int i = 0; i < 4; ++i) { gv[s][2 * i] = pg8::bflo(graw[i]); gv[s][2 * i + 1] = pg8::bfhi(graw[i]); } }
            float tot[4], pt[4], offs[4], off = 0.f;
#pragma unroll
            for (int s = 0; s < 4; ++s) {
#pragma unroll
                for (int jj = 1; jj < 8; ++jj) gv[s][jj] += gv[s][jj - 1];
                tot[s] = gv[s][7]; }
#pragma unroll
            for (int s = 0; s < 4; ++s) pt[s] = __shfl_xor(tot[s], 32);
#pragma unroll
            for (int s = 0; s < 4; ++s) { offs[s] = off + (hh ? pt[s] : 0.f); off += tot[s] + pt[s]; }
            const float glast = off;
#pragma unroll
            for (int s = 0; s < 4; ++s) { float kk[8];
#pragma unroll
                for (int i = 0; i < 4; ++i) { kk[2 * i] = pg8::bflo(kraw[s][i]); kk[2 * i + 1] = pg8::bfhi(kraw[s][i]); }
#pragma unroll
                for (int jj = 0; jj < 8; ++jj) kk[jj] *= __expf(glast - (offs[s] + gv[s][jj]));
                af[db][s] = pack_frag(kk[0], kk[1], kk[2], kk[3], kk[4], kk[5], kk[6], kk[7]); }
            if (eh == 0 && hh == 0) DEC[(size_t)(it >> 1) * 64 + dl] = __expf(glast);
        }
        f32x16 acc[2][2];
#pragma unroll
        for (int db = 0; db < 2; ++db)
#pragma unroll
            for (int eb = 0; eb < 2; ++eb)
#pragma unroll
                for (int i = 0; i < 16; ++i) acc[db][eb][i] = 0.f;
#pragma unroll
        for (int eb = 0; eb < 2; ++eb)
#pragma unroll
            for (int s = 0; s < 4; ++s) { const bf16x8 vf = *(const bf16x8*)(Vtb + ((size_t)((b * 4 + h) * 64 + n) * 128 + 64 * eh + 32 * eb + r) * 64 + 16 * s + 8 * hh);
#pragma unroll
                for (int db = 0; db < 2; ++db) acc[db][eb] = MFMA32(af[db][s], vf, acc[db][eb]); }
#pragma unroll
        for (int db = 0; db < 2; ++db)
#pragma unroll
            for (int eb = 0; eb < 2; ++eb)
#pragma unroll
                for (int q = 0; q < 4; ++q) KV[((((size_t)it * 2 + db) * 2 + eb) * 4 + q) * 64 + lane] = (v2u){pk2(acc[db][eb][4 * q], acc[db][eb][4 * q + 1]), pk2(acc[db][eb][4 * q + 2], acc[db][eb][4 * q + 3])};
    }
}
__device__ __forceinline__ void gla_scan_phase(Frame& F, unsigned char* ws, const unsigned char* kvbuf) {
    const bf16* KV = (const bf16*)kvbuf; const float* DEC = (const float*)(ws + WS_DEC); unsigned char* ST = (unsigned char*)kvbuf - 4 * MiB;
    for (int t2 = F.r * (NWAVES * 64) + F.tid; t2 < 4 * 4096; t2 += F.nl * NWAVES * 64) {
        const int half = t2 & 1, t = t2 >> 1;
        const int lane = t & 63, q = (t >> 6) & 3, eb = (t >> 8) & 1, db = (t >> 9) & 1, eh = (t >> 10) & 1, h = t >> 11, b = F.x, hi = lane >> 5;
        const int d0 = 32 * db + 16 * (q >> 1) + 8 * hi + 4 * (q & 1) + 2 * half;
        f32x2_t S = (f32x2_t){0.f, 0.f};
#pragma unroll 32
        for (int n = 0; n < NCH; ++n) {
            const size_t cu = ((size_t)(b * NCH + n) * 4 + h); const size_t slot = ((((cu * 2 + eh) * 2 + db) * 2 + eb) * 4 + q) * 64 + lane;
            const unsigned kw = *(const unsigned*)(KV + slot * 4 + 2 * half); const f32x2_t kv = (f32x2_t){pg8::bflo(kw), pg8::bfhi(kw)}; const f32x2_t dc = *(const f32x2_t*)(DEC + cu * 64 + d0);
            *(unsigned*)(ST + (((((cu * 2 + eh) * 2 + db) * 2 + eb) * 2 + (q >> 1)) * 64 + lane) * 16 + (q & 1) * 8 + half * 4) = pk2(S[0], S[1]);
            S = dc * S + kv;
        }
    }
}
template <int IB> __device__ __forceinline__ void gla_main_item(unsigned char* ws, const float* par, bf16* Y, int cu, int h, size_t t0, int lane, LAS unsigned char* tl, const unsigned char* stbuf) {
    const bf16* Bq = (const bf16*)(ws + WS_BQ); const bf16* Bk = (const bf16*)(ws + WS_BK); const bf16* Gg = (const bf16*)(ws + WS_GG); const bf16* Br = (const bf16*)(ws + WS_BR);
    const bf16* Vtb = (const bf16*)(ws + WS_VTB); const unsigned char* ST = stbuf;
    const int r = lane & 31, hh = lane >> 5, tix = ((cu >> 8) * 4 + h) * 64 + ((cu >> 2) & 63);
    asm volatile("s_waitcnt lgkmcnt(0)" ::: "memory");
#pragma unroll
    for (int j = 0; j < 8; ++j) __builtin_amdgcn_global_load_lds((const unsigned*)(Br + (t0 + 32 * IB + 4 * j + (lane >> 4)) * 512 + h * 128 + (lane & 15) * 8), (LAS unsigned*)(tl + j * 1024), 16, 0, 0);
    v4u qraw[4], kraw[IB + 1][4], stv[16]; bf16x8 gt[2][2 * (IB + 1)];
    { const bf16* gtp = (const bf16*)(ws + WS_GTT) + ((size_t)tix * 64) * 64;
#pragma unroll
      for (int db = 0; db < 2; ++db)
#pragma unroll
          for (int ks = 0; ks < 2 * (IB + 1); ++ks) gt[db][ks] = *(const bf16x8*)(gtp + (size_t)(32 * db + pi32(r)) * 64 + 16 * ks + 8 * hh); }
#pragma unroll
    for (int jb = 0; jb <= IB; ++jb) {
        const bf16* kp = Bk + (t0 + 32 * jb + r) * 256 + h * 64 + 8 * hh;
#pragma unroll
        for (int d0 = 0; d0 < 4; ++d0) kraw[jb][d0] = *(const v4u*)(kp + 16 * d0); }
    { const bf16* qp = Bq + (t0 + 32 * IB + r) * 256 + h * 64 + 8 * hh;
#pragma unroll
      for (int d0 = 0; d0 < 4; ++d0) qraw[d0] = *(const v4u*)(qp + 16 * d0); }
#pragma unroll
    for (int eb = 0; eb < 4; ++eb)
#pragma unroll
        for (int d0 = 0; d0 < 4; ++d0) { const int db = d0 >> 1, sg = d0 & 1, eh = eb >> 1, e2 = eb & 1;
            stv[eb * 4 + d0] = *(const v4u*)(ST + ((((((size_t)cu * 2 + eh) * 2 + db) * 2 + e2) * 2 + sg) * 64 + lane) * 16); }
    __builtin_amdgcn_sched_barrier(0);
    float gg[IB + 1][4][8];
    { v4u t0w, t1w; const v4u onew = (v4u){0x3F803F80u, 0x3F803F80u, 0x3F803F80u, 0x3F803F80u};
#pragma unroll
      for (int i = 0; i < 4; ++i) { const int s = 8 * hh + 2 * i;
          t0w[i] = (s <= r ? 0x3F80u : 0u) | (s + 1 <= r ? 0x3F800000u : 0u); t1w[i] = (16 + s <= r ? 0x3F80u : 0u) | (17 + s <= r ? 0x3F800000u : 0u); }
      const bf16x8 tri0 = __builtin_bit_cast(bf16x8, t0w), tri1 = __builtin_bit_cast(bf16x8, t1w), ones = __builtin_bit_cast(bf16x8, onew);
#pragma unroll
      for (int jb = 0; jb <= IB; ++jb)
#pragma unroll
          for (int db = 0; db < 2; ++db) { f32x16 c;
#pragma unroll
              for (int i = 0; i < 16; ++i) c[i] = 0.f;
              if (jb == 1) { c = MFMA32(gt[db][0], ones, c); c = MFMA32(gt[db][1], ones, c); }
              c = MFMA32(gt[db][2 * jb], tri0, c); c = MFMA32(gt[db][2 * jb + 1], tri1, c);
#pragma unroll
              for (int i = 0; i < 16; ++i) gg[jb][2 * db + (i >> 3)][i & 7] = c[i]; } }
    bf16x8 qd[4];
#pragma unroll
    for (int d0 = 0; d0 < 4; ++d0) { float qq[8];
#pragma unroll
        for (int i = 0; i < 4; ++i) { qq[2 * i] = pg8::bflo(qraw[d0][i]); qq[2 * i + 1] = pg8::bfhi(qraw[d0][i]); }
#pragma unroll
        for (int jj = 0; jj < 8; ++jj) qq[jj] *= __expf(gg[IB][d0][jj]);
        qd[d0] = pack_frag(qq[0], qq[1], qq[2], qq[3], qq[4], qq[5], qq[6], qq[7]); }
    f32x16 o[4];
#pragma unroll
    for (int eb = 0; eb < 4; ++eb)
#pragma unroll
        for (int i = 0; i < 16; ++i) o[eb][i] = 0.f;
#pragma unroll
    for (int eb = 0; eb < 4; ++eb)
#pragma unroll
        for (int d0 = 0; d0 < 4; ++d0) o[eb] = MFMA32(qd[d0], __builtin_bit_cast(bf16x8, stv[eb * 4 + d0]), o[eb]);
#pragma unroll
    for (int jb = 0; jb <= IB; ++jb) {
        f32x16 st;
#pragma unroll
        for (int i = 0; i < 16; ++i) st[i] = 0.f;
#pragma unroll
        for (int d0 = 0; d0 < 4; ++d0) { float kk[8];
#pragma unroll
            for (int i = 0; i < 4; ++i) { kk[2 * i] = pg8::bflo(kraw[jb][d0][i]); kk[2 * i + 1] = pg8::bfhi(kraw[jb][d0][i]); }
#pragma unroll
            for (int jj = 0; jj < 8; ++jj) kk[jj] *= __expf(-gg[jb][d0][jj]);
            st = MFMA32(pack_frag(kk[0], kk[1], kk[2], kk[3], kk[4], kk[5], kk[6], kk[7]), qd[d0], st); }
        if (jb == IB) {
#pragma unroll
            for (int i = 0; i < 16; ++i) if (crow(i, hh) > r) st[i] = 0.f;
        }
#pragma unroll
        for (int sg = 0; sg < 2; ++sg) {
            const bf16x8 pf = pack_frag(st[8 * sg], st[8 * sg + 1], st[8 * sg + 2], st[8 * sg + 3], st[8 * sg + 4], st[8 * sg + 5], st[8 * sg + 6], st[8 * sg + 7]);
#pragma unroll
            for (int eb = 0; eb < 4; ++eb) {
                const bf16* vp = Vtb + ((size_t)tix * 128 + 32 * eb + r) * 64 + 32 * jb + 16 * sg + 4 * hh;
                const v2u lo = *(const v2u*)vp, hi2 = *(const v2u*)(vp + 8); const v4u vv = (v4u){lo.x, lo.y, hi2.x, hi2.y};
                o[eb] = MFMA32(pf, __builtin_bit_cast(bf16x8, vv), o[eb]); }
        }
    }
    float ss[16];
#pragma unroll
    for (int i = 0; i < 16; ++i) ss[i] = (o[0][i] * o[0][i] + o[1][i] * o[1][i]) + (o[2][i] * o[2][i] + o[3][i] * o[3][i]);
#pragma unroll
    for (int of = 1; of < 32; of <<= 1) { float t[16];
#pragma unroll
        for (int i = 0; i < 16; ++i) t[i] = __shfl_xor(ss[i], of);
#pragma unroll
        for (int i = 0; i < 16; ++i) ss[i] += t[i]; }
#pragma unroll
    for (int i = 0; i < 16; ++i) ss[i] = rsqrtf(ss[i] * (1.0f / 128.0f) + pg8::RMS_EPS);
    asm volatile("s_waitcnt vmcnt(0)" ::: "memory");
#pragma unroll
    for (int eb = 0; eb < 4; ++eb) { const float g = par[PAR_OUTG + 32 * eb + r];
#pragma unroll
        for (int i = 0; i < 16; ++i) { LAS bf16* const p = (LAS bf16*)(tl + crow(i, hh) * 256 + (32 * eb + r) * 2); const float sr = bf2f(*p); *p = f2bf(o[eb][i] * ss[i] * g * sr); } }
    LDS_WAIT(); asm volatile("" ::: "memory");
#pragma unroll
    for (int j = 0; j < 8; ++j) { const int row = 4 * j + (lane >> 4), ch = lane & 15; const v4u vv = *(const LAS v4u*)(tl + row * 256 + ch * 16);
        *(v4u*)(Y + (t0 + 32 * IB + row) * 1024 + 512 + h * 128 + ch * 8) = vv; }
}
__device__ __forceinline__ void gla_main_phase(Frame& F, unsigned char* ws, const float* par, bf16* Y, const unsigned char* stbuf) {
    const bool bypanel = F.nl == 32;
    for (int itl = F.r * NWAVES + F.wave; itl < NCH * 4 * 2; itl += F.nl * NWAVES) {
        const int b = F.x, it = bypanel ? ((((itl >> 8) * 32 + 4 * (F.r & 7) + (F.r >> 3)) << 3) | (itl & 7)) : b * 512 + itl, ib = it & 1, h = (it >> 1) & 3, n = (it >> 3) & 63; const size_t t0 = (size_t)b * SEQ + 64 * n;
        LAS unsigned char* const tl = F.lds + RING_OFF + F.wave * 16384;
        const int lane_ = pg8::opaque_i(F.lane);
        if (ib == 0) gla_main_item<0>(ws, par, Y, it >> 1, h, t0, lane_, tl, stbuf); else gla_main_item<1>(ws, par, Y, it >> 1, h, t0, lane_, tl, stbuf);
    }
}

__global__ void __launch_bounds__(NWAVES * 64, 2) mk_fwd(Args args) {
    extern __shared__ __attribute__((aligned(16))) unsigned char lds[];
    unsigned char* const ws = args.ws;
    volatile LAS unsigned* const MISC = (volatile LAS unsigned*)((LAS unsigned char*)lds + MISC_OFF);
    { const int tid = threadIdx.x; for (int u = tid; u < (LDS_BYTES - LDSCTL_OFF) / 4; u += NWAVES * 64) ((LAS unsigned*)((LAS unsigned char*)lds + LDSCTL_OFF))[u] = 0u; }
    __syncthreads();
    { const XcdBarrier bar = xcd_barrier_post((unsigned*)(ws + WS_CTL) + CW_BAR, MISC + 8); if (threadIdx.x == 0) MISC[20] = bar.x; }
    if (threadIdx.x == 0) {
        const unsigned x = xb_xcc_id();
        MISC[16] = x; MISC[17] = __hip_atomic_fetch_add((unsigned*)(ws + WS_CTL) + CW_RANK + 64 * (x & 15u), 1u, __ATOMIC_RELAXED, __HIP_MEMORY_SCOPE_AGENT); MISC[18] = 1u;
    }
    __syncthreads();
#define GRID_BAR() do { volatile LAS unsigned* const M_ = (volatile LAS unsigned*)((LAS unsigned char*)lds + pg8::opaque_i(MISC_OFF)); XcdBarrier b_; b_.bar = (unsigned*)(ws + WS_CTL) + CW_BAR; b_.x = M_[20]; b_.st = M_ + 8; xcd_barrier(b_, M_[19] == 0u); } while (0)
    { Frame F = make_frame(lds); p0_weights(F, args); }
    GRID_BAR();
    if (threadIdx.x == 0) {
        const unsigned* xc = (const unsigned*)(ws + WS_CTL) + CW_BAR; unsigned cnt[16], tot = 0; bool ok = true;
#pragma unroll
        for (int j = 0; j < 16; ++j) { cnt[j] = __hip_atomic_load(xc + XB_XCNT(j), __ATOMIC_RELAXED, __HIP_MEMORY_SCOPE_AGENT); tot += cnt[j]; ok = ok && (j < 8 ? cnt[j] > 0u : cnt[j] == 0u); }
        ok = ok && tot == gridDim.x;
        const unsigned x = MISC[16];
        MISC[19] = ok ? 1u : 0u;
        if (ok) { unsigned nl = 0;
#pragma unroll
            for (int j = 0; j < 8; ++j) nl = (j == (int)x) ? cnt[j] : nl;
            MISC[18] = nl; }
        else { const unsigned G = gridDim.x, bx = blockIdx.x; MISC[16] = bx & 7u; MISC[17] = bx >> 3; MISC[18] = (G - (bx & 7u) + 7u) >> 3; }
    }
    __syncthreads();
#define ARENA_PTR(F) (ws + WS_ARENA0 + (size_t)(F).xr * ARENA)
#define PANEL_SEAM(s) do { volatile LAS unsigned* const M_ = (volatile LAS unsigned*)((LAS unsigned char*)lds + pg8::opaque_i(MISC_OFF)); \
    if (__builtin_amdgcn_readfirstlane((int)M_[19]) != 0 && __builtin_amdgcn_readfirstlane((int)M_[18]) == 32) \
        head_group_sync((unsigned*)(ws + WS_CTL) + CW_GRP + 8192 + (s) * 8192 + ((l * 8 + (int)(M_[16] & 7u)) * 8 + (int)(M_[17] & 7u)) * 32, (unsigned*)(ws + WS_CTL) + CW_BAR + XB_TMO, 4u); \
    else GRID_BAR(); } while (0)
#define X8_PTR(F) ((unsigned char*)args.out + (size_t)(F).xr * (16 * MiB) + 8 * MiB)
    { Frame F = make_frame(lds); p0_x(F, args, ARENA_PTR(F), X8_PTR(F)); }
    GRID_BAR();
    for (int l = 0; l < DEPTH; ++l) {
        unsigned char* const wl = ws + WS_W0 + (size_t)l * W_LAYER; const float* const par = (const float*)(ws + WS_PAR + (size_t)l * PAR_LAYER_BYTES);
        {   Frame F = make_frame(lds); z_phase(F, ARENA_PTR(F), wl, par); fill_rstd_lds(F, (const float*)(ARENA_PTR(F) + WS_PARTA)); }
        {   Frame F = make_frame(lds); unsigned char* const wsb = ARENA_PTR(F);
            pg8::Gemm g{(const pg8::bf16_t*)X8_PTR(F), (const pg8::bf16_t*)(wl + WO_IN_G8), SEQ, 8 * 256, DM / 2}; XcdOrder<8, false> S{F.x, F.r, F.nl};
            pg8::EpiGate E{(const LAS float*)((LAS unsigned char*)lds + RSTD_LDS_OFF), wsb};
            pg8::gemm_phase<pg8::EpiGate, XcdOrder<8, false>, true, true, false, true>((LAS unsigned char*)lds + RING_OFF, g, S, E); }
        {   Frame F = make_frame(lds); unsigned char* const wsb = ARENA_PTR(F); pg8::Gemm g{(const pg8::bf16_t*)(wl + WO_IN_T), (const pg8::bf16_t*)(wsb + WS_XB), NIN_T, SEQ, DM}; XcdOrder<NIN_T / 256, true> S{F.x, F.r, F.nl};
            pg8::EpiInT E{(const LAS float*)((LAS unsigned char*)lds + RSTD_LDS_OFF), wsb, par};
            pg8::gemm_phase<pg8::EpiInT, XcdOrder<NIN_T / 256, true>, true, true>((LAS unsigned char*)lds + RING_OFF, g, S, E); }
        {   Frame F = make_frame(lds); unsigned char* const wsb = ARENA_PTR(F);
            pg8::Gemm g{(const pg8::bf16_t*)(wsb + WS_XB), (const pg8::bf16_t*)(wl + WO_IN_N), SEQ, 9 * 256, DM}; XcdOrder<8, false, 6> S{F.x, F.r, F.nl};
            pg8::EpiInN E{(const LAS float*)((LAS unsigned char*)lds + RSTD_LDS_OFF), wsb, par, 0};
            pg8::gemm_phase<pg8::EpiInN, XcdOrder<8, false, 6>, true, true>((LAS unsigned char*)lds + RING_OFF, g, S, E); }
        GRID_BAR();
#define Y_PTR(F) ((bf16*)((unsigned char*)args.out + (size_t)(F).xr * (16 * MiB)))
        {   Frame F = make_frame(lds); attn_phase(F, ARENA_PTR(F), par, Y_PTR(F)); gla_kv_phase(F, ARENA_PTR(F), X8_PTR(F) + 4 * MiB);
            const bool grp = (((volatile LAS unsigned*)((LAS unsigned char*)lds + pg8::opaque_i(MISC_OFF)))[19] != 0u) && F.nl == 32;
            if (grp) head_group_sync((unsigned*)(ws + WS_CTL) + CW_GRP + ((l * 8 + F.xr) * 4 + (F.r >> 3)) * 32, (unsigned*)(ws + WS_CTL) + CW_BAR + XB_TMO); else GRID_BAR();
            gla_scan_phase(F, ARENA_PTR(F), X8_PTR(F) + 4 * MiB); }
        GRID_BAR();
        { Frame F = make_frame(lds); gla_main_phase(F, ARENA_PTR(F), par, Y_PTR(F), X8_PTR(F)); }
        PANEL_SEAM(2);
        {   Frame F = make_frame(lds); unsigned char* const wsb = ARENA_PTR(F); pg8::Gemm g{(const pg8::bf16_t*)Y_PTR(F), (const pg8::bf16_t*)(wl + WO_BR), SEQ, DM, DM}; XcdOrder<4, false> S{F.x, F.r, F.nl};
            pg8::EpiBranch E{wsb};
            pg8::gemm_phase<pg8::EpiBranch, XcdOrder<4, false>, false, true>((LAS unsigned char*)lds + RING_OFF, g, S, E); }
        PANEL_SEAM(0);
        {   Frame F = make_frame(lds); unsigned char* const wsb = ARENA_PTR(F); pg8::Gemm g{(const pg8::bf16_t*)(wsb + WS_MIX), (const pg8::bf16_t*)(wl + WO_OUT), SEQ, DM, DM}; XcdOrder<4, false> S{F.x, F.r, F.nl};
            pg8::EpiRes E{(pg8::bf16_t*)(wsb + WS_XB), (float*)(wsb + WS_PARTF), nullptr, nullptr};
            pg8::gemm_phase<pg8::EpiRes, XcdOrder<4, false>, false, true>((LAS unsigned char*)lds + RING_OFF, g, S, E); }
        GRID_BAR();
        {   Frame F = make_frame(lds); unsigned char* const wsb = ARENA_PTR(F); fill_rstd_lds(F, (const float*)(wsb + WS_PARTF));
            pg8::Gemm g{(const pg8::bf16_t*)(wsb + WS_XB), (const pg8::bf16_t*)(wl + WO_UP), SEQ, DFF, DM}; XcdOrder<16, false> S{F.x, F.r, F.nl};
            pg8::EpiUp E{(const LAS float*)((LAS unsigned char*)lds + RSTD_LDS_OFF), wsb};
            pg8::gemm_phase<pg8::EpiUp, XcdOrder<16, false>, true, true>((LAS unsigned char*)lds + RING_OFF, g, S, E); }
        GRID_BAR();
        {   Frame F = make_frame(lds); unsigned char* const wsb = ARENA_PTR(F); pg8::Gemm g{(const pg8::bf16_t*)(wsb + WS_HID), (const pg8::bf16_t*)(wl + WO_DN), SEQ, DM, DFF}; XcdOrder<4, false> S{F.x, F.r, F.nl};
            pg8::EpiRes E{(pg8::bf16_t*)(wsb + WS_XB), (float*)(wsb + WS_PARTA), l == DEPTH - 1 ? args.out + (size_t)F.xr * SEQ * DM : nullptr, l == DEPTH - 1 ? nullptr : X8_PTR(F)};
            pg8::gemm_phase<pg8::EpiRes, XcdOrder<4, false>, false, true, true>((LAS unsigned char*)lds + RING_OFF, g, S, E); }
        if (l < DEPTH - 1) GRID_BAR();
    }
    if (__hip_atomic_load((unsigned*)(ws + WS_CTL) + CW_BAR + XB_TMO, __ATOMIC_RELAXED, __HIP_MEMORY_SCOPE_AGENT) != 0u) {
        const float qn = __builtin_nanf(""); const int tid = threadIdx.x;
        for (size_t i = (size_t)blockIdx.x * 512 + tid; i < (size_t)MT * DM / 4; i += (size_t)gridDim.x * 512) ((f32x4*)args.out)[i] = (f32x4){qn, qn, qn, qn};
    }
}

extern "C" void kernel_launch(void* const* d_in, const int* in_sizes, int n_in, void* d_out, int out_size, void* d_ws, size_t ws_size, hipStream_t stream) {
    static int grid = 0;
    if (grid == 0) {
        if (n_in != 18 || out_size != MT * DM || ws_size < WS_END) { fprintf(stderr, "kernel_launch: unexpected problem (n_in %d, out %d, ws %zu)\n", n_in, out_size, ws_size); grid = -1; return; }
        int dev = 0, cus = 0, per_cu = 0;
        if (hipGetDevice(&dev) != hipSuccess || hipDeviceGetAttribute(&cus, hipDeviceAttributeMultiprocessorCount, dev) != hipSuccess) { grid = -1; return; }
        if (hipFuncSetAttribute((const void*)mk_fwd, hipFuncAttributeMaxDynamicSharedMemorySize, LDS_BYTES) != hipSuccess) { grid = -1; return; }
        if (hipOccupancyMaxActiveBlocksPerMultiprocessor(&per_cu, (const void*)mk_fwd, NWAVES * 64, LDS_BYTES) != hipSuccess || per_cu < 1) { fprintf(stderr, "kernel_launch: occupancy query reports %d\n", per_cu); }
        (void)hipGetLastError();
        grid = cus;
    }
    if (grid < 0) return;
    if (hipMemsetAsync((char*)d_ws + WS_CTL, 0, CTL_ZERO_BYTES, stream) != hipSuccess) return;
    Args a{};
    a.x = (const float*)d_in[0]; a.norm_mix = (const float*)d_in[1]; a.w_in = (const float*)d_in[2]; a.a_q_norm = (const float*)d_in[3]; a.a_k_norm = (const float*)d_in[4];
    a.lq1 = (const float*)d_in[5]; a.lk1 = (const float*)d_in[6]; a.lq2 = (const float*)d_in[7]; a.lk2 = (const float*)d_in[8]; a.a_sub_norm = (const float*)d_in[9];
    a.b_gate_up = (const float*)d_in[10]; a.b_gate_bias = (const float*)d_in[11]; a.b_out_norm = (const float*)d_in[12]; a.w_branch = (const float*)d_in[13]; a.w_out = (const float*)d_in[14];
    a.norm_ffn = (const float*)d_in[15]; a.w_up = (const float*)d_in[16]; a.w_down = (const float*)d_in[17];
    a.out = (float*)d_out; a.ws = (unsigned char*)d_ws;
    for (int l = 0; l < 4; ++l) a.lam_init[l] = (float)(0.8 - 0.6 * exp(-0.3 * l));
    a.ph_lo = 0; a.ph_hi = 0;
    hipLaunchKernelGGL(mk_fwd, dim3(grid), dim3(NWAVES * 64), LDS_BYTES, stream, a);
}
```
